# Optimizing an MI355X kernel written in HIP

```python
import math
import jax, jax.numpy as jnp
from jax import lax
import numpy as np

D_MODEL = 1024
BATCH = 2
SEQ = 8192
DEPTH = 1

CHUNK = 64
POOL_WINDOWS = (2, 4, 8, 16)
N_POOL_GROUPS = len(POOL_WINDOWS)
D_POOL = D_MODEL
POOL_GROUP = D_POOL // N_POOL_GROUPS
RET_HEADS = 4
RET_DK = D_MODEL // RET_HEADS
RET_DV = 2 * D_MODEL // RET_HEADS
D_RET_QK = RET_HEADS * RET_DK
D_RET_V = RET_HEADS * RET_DV
ROPE_BASE = 10000.0
NORM_EPS = 1e-6
IN_SPLITS = (D_POOL, D_POOL, D_RET_QK, D_RET_QK, D_RET_V, D_RET_V, D_MODEL, D_MODEL)
D_IN = sum(IN_SPLITS)

kernel_name = "hybrid_pool_retention_gated_block"


def rms_norm(x, gain, eps=NORM_EPS):
    xf = x.astype(jnp.float32)
    y = xf * lax.rsqrt(jnp.mean(xf * xf, axis=-1, keepdims=True) + eps)
    return (y * gain.astype(jnp.float32)).astype(x.dtype)


def rotary(t, pos):
    half = t.shape[-1] // 2
    inv_freq = 1.0 / (ROPE_BASE ** (jnp.arange(half, dtype=jnp.float32) / half))
    ang = pos.astype(jnp.float32)[:, None] * inv_freq[None, :]
    cos = jnp.cos(ang)[None, :, None, :]
    sin = jnp.sin(ang)[None, :, None, :]
    t1, t2 = t[..., :half], t[..., half:]
    return jnp.concatenate([t1 * cos - t2 * sin, t1 * sin + t2 * cos], axis=-1)


def pool_mixer(u, w_pool, pool_scale):
    b, s, _ = u.shape
    uf = u.astype(jnp.float32)
    pos1 = jnp.arange(s, dtype=jnp.int32) + 1
    outs = []
    for g, w in enumerate(POOL_WINDOWS):
        seg = uf[..., g * POOL_GROUP:(g + 1) * POOL_GROUP]
        cs = jnp.cumsum(seg, axis=1)
        prev = jnp.pad(cs, ((0, 0), (w, 0), (0, 0)))[:, :s]
        cnt = jnp.minimum(pos1, w).astype(jnp.float32)[None, :, None]
        outs.append((cs - prev) / cnt - seg)
    pooled = jnp.stack(outs, axis=2)
    mixed = jnp.einsum('bsgc,gcd->bsgd', pooled, w_pool.astype(jnp.float32))
    mixed = mixed.reshape(b, s, D_POOL) * pool_scale.astype(jnp.float32)
    return mixed


def retention(q, k, v):
    b, s, h, dk = q.shape
    dv = v.shape[-1]
    nc = s // CHUNK
    gamma = 1.0 - jnp.exp2(-5.0 - jnp.arange(h, dtype=jnp.float32))
    log_g = jnp.log(gamma)
    idx = jnp.arange(CHUNK, dtype=jnp.float32)
    dist = jnp.abs(idx[:, None] - idx[None, :])
    decay_in = jnp.exp(log_g[:, None, None] * dist)
    xi = jnp.exp(log_g[None, :] * (idx[:, None] + 1.0))
    zeta = jnp.exp(log_g[None, :] * (CHUNK - 1.0 - idx[:, None]))
    g_chunk = jnp.exp(log_g * CHUNK)

    q = q * (dk ** -0.5)
    qc = q.reshape(b, nc, CHUNK, h, dk)
    kc = k.reshape(b, nc, CHUNK, h, dk)
    vc = v.reshape(b, nc, CHUNK, h, dv)

    scores = jnp.einsum('bnihd,bnjhd->bnhij', qc, kc) * decay_in[None, None]
    o_inner = jnp.einsum('bnhij,bnjhe->bnihe', scores, vc)

    def step(state, inp):
        q_i, k_i, v_i = inp
        cross = jnp.einsum('bihd,bhde->bihe', q_i, state) * xi[None, :, :, None]
        new_state = state * g_chunk[None, :, None, None] + jnp.einsum(
            'bihd,bihe->bhde', k_i * zeta[None, :, :, None], v_i)
        return new_state, cross

    state0 = jnp.zeros((b, h, dk, dv), jnp.float32)
    _, cross = lax.scan(step, state0, (jnp.moveaxis(qc, 1, 0), jnp.moveaxis(kc, 1, 0),
                                       jnp.moveaxis(vc, 1, 0)))
    o = o_inner + jnp.moveaxis(cross, 0, 1)
    o = o.reshape(b, s, h, dv)
    o = o * lax.rsqrt(jnp.mean(o * o, axis=-1, keepdims=True) + NORM_EPS)
    return o.reshape(b, s, h * dv)


def setup_inputs(seed: int = 0) -> dict:
    key = jax.random.key(seed)
    ks = jax.random.split(key, 10)
    f32 = jnp.float32
    x = jax.random.normal(ks[0], (BATCH, SEQ, D_MODEL), f32)
    norm_in = 1.0 + 0.02 * jax.random.normal(ks[1], (D_MODEL,), f32)
    w_in = jax.random.normal(ks[2], (D_MODEL, D_IN), f32) * D_MODEL ** -0.5
    w_pool = jax.random.normal(ks[3], (N_POOL_GROUPS, POOL_GROUP, POOL_GROUP), f32) * POOL_GROUP ** -0.5
    pool_scale = 1.0 + 0.02 * jax.random.normal(ks[4], (D_POOL,), f32)
    w_a = jax.random.normal(ks[5], (D_POOL, D_MODEL), f32) * D_POOL ** -0.5
    w_b = jax.random.normal(ks[6], (D_RET_V, D_MODEL), f32) * D_RET_V ** -0.5
    w_o = jax.random.normal(ks[7], (D_MODEL, D_MODEL), f32) * D_MODEL ** -0.5
    norm_out = 1.0 + 0.02 * jax.random.normal(ks[8], (D_MODEL,), f32)
    return {"x": x, "norm_in": norm_in, "w_in": w_in, "w_pool": w_pool,
            "pool_scale": pool_scale, "w_a": w_a, "w_b": w_b, "w_o": w_o,
            "norm_out": norm_out}


def reference(x, norm_in, w_in, w_pool, pool_scale, w_a, w_b, w_o, norm_out):
    b, s, _ = x.shape
    pos = jnp.arange(s, dtype=jnp.int32)
    for _layer in range(DEPTH):
        h = rms_norm(x, norm_in)
        proj = jnp.einsum('bsd,de->bse', h, w_in)
        offs = np.cumsum((0,) + IN_SPLITS)
        a_in, a_gate, q, k, v, r_gate, g_a, g_b = [
            proj[..., offs[i]:offs[i + 1]] for i in range(len(IN_SPLITS))]

        ya = pool_mixer(a_in, w_pool, pool_scale) * jax.nn.silu(a_gate.astype(jnp.float32))
        ya = jnp.einsum('bsc,cd->bsd', ya.astype(x.dtype), w_a)

        qf = rotary(q.astype(jnp.float32).reshape(b, s, RET_HEADS, RET_DK), pos)
        kf = rotary(k.astype(jnp.float32).reshape(b, s, RET_HEADS, RET_DK), pos)
        vf = v.astype(jnp.float32).reshape(b, s, RET_HEADS, RET_DV)
        yb = retention(qf, kf, vf) * jax.nn.silu(r_gate.astype(jnp.float32))
        yb = jnp.einsum('bsc,cd->bsd', yb.astype(x.dtype), w_b)

        merged = jax.nn.sigmoid(g_a) * ya + jax.nn.sigmoid(g_b) * yb
        x = x + jnp.einsum('bsd,de->bse', merged, w_o)
    return rms_norm(x, norm_out)
```

```cpp
#include <hip/hip_runtime.h>
#include <stdint.h>

typedef unsigned short bf16;
typedef _Float16 h2_t __attribute__((ext_vector_type(2)));

constexpr int M_TOK = 16384, SEQ = 8192, DM = 1024, DIN = 10240;
constexpr float NORM_EPS = 1e-6f;
constexpr size_t MiB = 1u << 20;
constexpr size_t WS_CTL = 0, WS_SSQ = 1 * MiB, WS_WPOOLT = 3 * MiB, WS_WAB = 4 * MiB, WS_WO = 10 * MiB, WS_TABPF = 12 * MiB, WS_TABFP = 16 * MiB,
                 WS_WIN = 20 * MiB, WS_XB = 40 * MiB, WS_Q = 72 * MiB, WS_KN = 104 * MiB, WS_KZT = 136 * MiB, WS_WS = 168 * MiB;
constexpr size_t WS_AIN = 72 * MiB, WS_YA = 104 * MiB, WS_SA = 136 * MiB, WS_SB = 168 * MiB, WS_POOLED = 200 * MiB, WS_MERGED = 40 * MiB;

__device__ __forceinline__ float bf2f(bf16 b) { return __uint_as_float(((unsigned)b) << 16); }
__device__ __forceinline__ bf16 f2bf(float f) { unsigned u = __float_as_uint(f); u += 0x7fffu + ((u >> 16) & 1u); return (bf16)(u >> 16); }
__device__ __forceinline__ float lg2gamma(int h) { return h == 0 ? -0.04580368961312479f : h == 1 ? -0.02272007650008353f : h == 2 ? -0.011315313227834146f : -0.005646563141142063f; }
__device__ __forceinline__ float siluf(float x) { return x / (1.f + __expf(-x)); }
__device__ __forceinline__ float sigmf(float x) { return 1.f / (1.f + __expf(-x)); }

__global__ void k_prep_x(const float* __restrict__ x, const float* __restrict__ g, bf16* __restrict__ xb) {
    const int row = blockIdx.x * 4 + (threadIdx.x >> 6), lane = threadIdx.x & 63;
    const float4* xr = (const float4*)(x + (size_t)row * DM);
    float4 v[4]; float s = 0.f;
#pragma unroll
    for (int j = 0; j < 4; ++j) { v[j] = xr[lane + 64 * j]; s += v[j].x * v[j].x + v[j].y * v[j].y + v[j].z * v[j].z + v[j].w * v[j].w; }
#pragma unroll
    for (int o = 1; o < 64; o <<= 1) s += __shfl_xor(s, o);
    const float rstd = 1.0f / sqrtf(s * (1.f / DM) + NORM_EPS);
#pragma unroll
    for (int j = 0; j < 4; ++j) { const float4 gg = ((const float4*)g)[lane + 64 * j];
        ushort4 o; o.x = f2bf(v[j].x * rstd * gg.x); o.y = f2bf(v[j].y * rstd * gg.y); o.z = f2bf(v[j].z * rstd * gg.z); o.w = f2bf(v[j].w * rstd * gg.w);
        ((ushort4*)(xb + (size_t)row * DM))[lane + 64 * j] = o; }
}
__global__ void k_transpose(const float* __restrict__ src, int K, int N, bf16* __restrict__ dst, int dpitch, const float* __restrict__ scale) {
    __shared__ float t[32][33];
    const int k0 = blockIdx.y * 32, n0 = blockIdx.x * 32, tx = threadIdx.x & 31, ty = threadIdx.x >> 5;
    for (int i = ty; i < 32; i += 8) t[i][tx] = src[(size_t)(k0 + i) * N + n0 + tx];
    __syncthreads();
    for (int i = ty; i < 32; i += 8) { const int n = n0 + i; const float sc = scale ? scale[n] : 1.f; dst[(size_t)n * dpitch + k0 + tx] = f2bf(t[tx][i] * sc); }
}
__device__ __forceinline__ void sincos_d(double ang, float& c, float& s) {
    const double q = rint(ang * 0.63661977236758134308);
    double t = fma(-q, 1.5707963267948966192, ang); t = fma(-q, 6.123233995736766e-17, t);
    const double t2 = t * t;
    double sp = -1.0 / 1307674368000.0; sp = sp * t2 + 1.0 / 6227020800.0; sp = sp * t2 - 1.0 / 39916800.0; sp = sp * t2 + 1.0 / 362880.0; sp = sp * t2 - 1.0 / 5040.0; sp = sp * t2 + 1.0 / 120.0; sp = sp * t2 - 1.0 / 6.0; sp = sp * t2 + 1.0; sp *= t;
    double cp = 1.0 / 20922789888000.0; cp = cp * t2 - 1.0 / 87178291200.0; cp = cp * t2 + 1.0 / 479001600.0; cp = cp * t2 - 1.0 / 3628800.0; cp = cp * t2 + 1.0 / 40320.0; cp = cp * t2 - 1.0 / 720.0; cp = cp * t2 + 1.0 / 24.0; cp = cp * t2 - 0.5; cp = cp * t2 + 1.0;
    const int n = ((int)q) & 3;
    const double ss = (n == 0) ? sp : (n == 1) ? cp : (n == 2) ? -sp : -cp;
    const double cc = (n == 0) ? cp : (n == 1) ? -sp : (n == 2) ? -cp : sp;
    c = (float)cc; s = (float)ss;
}
__global__ void k_tables(h2_t* __restrict__ pf, h2_t* __restrict__ fp) {
    const int idx = blockIdx.x * blockDim.x + threadIdx.x;
    const int pos = idx >> 7, f = idx & 127;
    const double inv = exp2(-(double)f * (13.287712379549449 / 128.0));
    float c, s; sincos_d((double)pos * inv, c, s);
    h2_t v; v.x = (_Float16)c; v.y = (_Float16)s;
    pf[idx] = v; fp[(size_t)f * SEQ + pos] = v;
}

template <class F>
__global__ void __launch_bounds__(256) k_gemm(F f) {
    __shared__ __attribute__((aligned(16))) float As[32][36];
    __shared__ __attribute__((aligned(16))) float Bs[256][36];
    const int tid = threadIdx.x, ty = tid >> 4, tx = tid & 15, z = blockIdx.y, rt = blockIdx.x;
    float acc[2][16];
#pragma unroll
    for (int i = 0; i < 2; ++i)
#pragma unroll
        for (int j = 0; j < 16; ++j) acc[i][j] = 0.f;
    const int ns = f.nseg();
    for (int s = 0; s < ns; ++s) {
        const bf16* A; const bf16* B; int K, lda, ldb; f.seg(z, rt, s, A, B, K, lda, ldb);
        for (int k0 = 0; k0 < K; k0 += 32) {
            { const int r = tid >> 3, kk = (tid & 7) * 4; const ushort4 a = *(const ushort4*)(A + (size_t)r * lda + k0 + kk);
              As[r][kk] = bf2f(a.x); As[r][kk + 1] = bf2f(a.y); As[r][kk + 2] = bf2f(a.z); As[r][kk + 3] = bf2f(a.w); }
            { const bf16* bp = B + (size_t)tid * ldb + k0;
#pragma unroll
              for (int q = 0; q < 4; ++q) { const uint4 b = *(const uint4*)(bp + q * 8); const unsigned w[4] = {b.x, b.y, b.z, b.w};
#pragma unroll
                  for (int e = 0; e < 4; ++e) { Bs[tid][q * 8 + 2 * e] = __uint_as_float(w[e] << 16); Bs[tid][q * 8 + 2 * e + 1] = __uint_as_float(w[e] & 0xffff0000u); } } }
            __syncthreads();
#pragma unroll
            for (int k4 = 0; k4 < 8; ++k4) {
                const float4 a0 = *(const float4*)&As[2 * ty][k4 * 4], a1 = *(const float4*)&As[2 * ty + 1][k4 * 4];
#pragma unroll
                for (int j = 0; j < 16; ++j) { const float4 b = *(const float4*)&Bs[tx + 16 * j][k4 * 4];
                    acc[0][j] += a0.x * b.x + a0.y * b.y + a0.z * b.z + a0.w * b.w; acc[1][j] += a1.x * b.x + a1.y * b.y + a1.z * b.z + a1.w * b.w; }
            }
            __syncthreads();
        }
        if (s + 1 < ns) { f.mid(z, rt, s, 2 * ty, tx, acc[0]); f.mid(z, rt, s, 2 * ty + 1, tx, acc[1]); }
    }
    f.store(z, rt, 2 * ty, tx, acc[0]); f.store(z, rt, 2 * ty + 1, tx, acc[1]);
}

struct F_G1R {
    const bf16* XB; const bf16* WIN; const h2_t* TABPF; bf16* Q; bf16* KN; bf16* KZT; bf16* VT;
    __device__ int nseg() const { return 1; }
    __device__ void seg(int z, int rt, int s, const bf16*& A, const bf16*& B, int& K, int& lda, int& ldb) const {
        int wrow; if (z < 4) wrow = 2048 + 256 * z; else if (z < 8) wrow = 3072 + 256 * (z - 4); else if (z < 12) wrow = 3072 + 256 * (z - 8); else wrow = 4096 + 256 * (z - 12);
        A = XB + (size_t)rt * 32 * DM; B = WIN + (size_t)wrow * DM; K = DM; lda = DM; ldb = DM; }
    __device__ void mid(int, int, int, int, int, float (&)[16]) const {}
    __device__ void store(int z, int rt, int r, int tx, float (&v)[16]) const {
        const int m = rt * 32 + r, b = m >> 13, pos = m & 8191, J = pos >> 8, i = pos & 255;
        if (z < 12) {
            const int h = z & 3, bh = b * 4 + h;
#pragma unroll
            for (int j = 0; j < 8; ++j) { const int d = tx + 16 * j; const h2_t cs = TABPF[pos * 128 + d]; const float c = (float)cs.x, s = (float)cs.y;
                float o1 = v[j] * c - v[j + 8] * s, o2 = v[j] * s + v[j + 8] * c;
                if (z < 4) { o1 *= 0.0625f; o2 *= 0.0625f; bf16* p = Q + ((size_t)bh * SEQ + pos) * 256; p[d] = f2bf(o1); p[d + 128] = f2bf(o2); }
                else if (z < 8) { bf16* p = KN + ((size_t)bh * SEQ + pos) * 256; p[d] = f2bf(o1); p[d + 128] = f2bf(o2); }
                else { const float zz = exp2f((float)(255 - i) * lg2gamma(h)); bf16* p = KZT + (size_t)(bh * 32 + J) * 65536 + i; p[(size_t)d * 256] = f2bf(o1 * zz); p[(size_t)(d + 128) * 256] = f2bf(o2 * zz); } }
        } else {
            const int sidx = z - 12;
            bf16* p = VT + ((size_t)sidx * M_TOK + b * SEQ + J * 256) * 256 + i;
#pragma unroll
            for (int j = 0; j < 16; ++j) p[(size_t)(tx + 16 * j) * 256] = f2bf(v[j]);
        }
    }
};
struct F_U1 {
    const bf16* Q; const bf16* KN; bf16* PB;
    __device__ int nseg() const { return 1; }
    __device__ void seg(int z, int rt, int s, const bf16*& A, const bf16*& B, int& K, int& lda, int& ldb) const { A = Q + (size_t)z * 65536 + rt * 32 * 256; B = KN + (size_t)z * 65536; K = 256; lda = 256; ldb = 256; }
    __device__ void mid(int, int, int, int, int, float (&)[16]) const {}
    __device__ void store(int z, int rt, int r, int tx, float (&v)[16]) const {
        const int i = rt * 32 + r, h = (z >> 5) & 3; const float lg = lg2gamma(h);
#pragma unroll
        for (int j = 0; j < 16; ++j) { const int jj = tx + 16 * j; const int dd = i > jj ? i - jj : jj - i;
            const float w = ((jj >> 6) <= (i >> 6)) ? exp2f((float)dd * lg) : 0.f; PB[(size_t)z * 65536 + i * 256 + jj] = f2bf(v[j] * w); }
    }
};
struct F_U2 {
    const bf16* VT; const bf16* KZT; bf16* WS;
    __device__ int nseg() const { return 1; }
    __device__ void seg(int z, int rt, int s, const bf16*& A, const bf16*& B, int& K, int& lda, int& ldb) const {
        const int bhJ = z >> 1, eh = z & 1, b = bhJ >> 7, h = (bhJ >> 5) & 3, J = bhJ & 31, sidx = h * 2 + eh;
        A = VT + ((size_t)sidx * M_TOK + b * SEQ + J * 256) * 256 + rt * 32 * 256; B = KZT + (size_t)bhJ * 65536; K = 256; lda = 256; ldb = 256; }
    __device__ void mid(int, int, int, int, int, float (&)[16]) const {}
    __device__ void store(int z, int rt, int r, int tx, float (&v)[16]) const {
        const int bhJ = z >> 1, eh = z & 1, e = eh * 256 + rt * 32 + r;
#pragma unroll
        for (int j = 0; j < 16; ++j) WS[(size_t)bhJ * 131072 + e * 256 + tx + 16 * j] = f2bf(v[j]);
    }
};
__global__ void k_prefix(bf16* __restrict__ WS) {
    const int idx = blockIdx.x * blockDim.x + threadIdx.x;
    const int bh = idx >> 17, off = idx & 131071, h = bh & 3;
    const float G = exp2f(256.f * lg2gamma(h));
    float s = 0.f;
    for (int J = 0; J < 32; ++J) { bf16* p = WS + ((size_t)(bh * 32 + J)) * 131072 + off; const float w = bf2f(*p); *p = f2bf(s); s = G * s + w; }
}
struct F_U3 {
    const bf16* Q; const bf16* WS; const bf16* PB; const bf16* VT; bf16* OUT; float* SSQ; int b0;
    __device__ int nseg() const { return 2; }
    __device__ void seg(int zz, int rt, int s, const bf16*& A, const bf16*& B, int& K, int& lda, int& ldb) const {
        const int z = zz + b0 * 256; const int bhJ = z >> 1, eh = z & 1, b = bhJ >> 7, h = (bhJ >> 5) & 3, J = bhJ & 31, sidx = h * 2 + eh;
        if (s == 0) { A = Q + (size_t)bhJ * 65536 + rt * 32 * 256; B = WS + (size_t)bhJ * 131072 + eh * 65536; }
        else { A = PB + (size_t)bhJ * 65536 + rt * 32 * 256; B = VT + ((size_t)sidx * M_TOK + b * SEQ + J * 256) * 256; }
        K = 256; lda = 256; ldb = 256; }
    __device__ void mid(int zz, int rt, int s, int r, int tx, float (&v)[16]) const {
        const int z = zz + b0 * 256; const int h = (z >> 6) & 3, i = rt * 32 + r; const float w = exp2f((float)(i + 1) * lg2gamma(h));
#pragma unroll
        for (int j = 0; j < 16; ++j) v[j] *= w; }
    __device__ void store(int zz, int rt, int r, int tx, float (&v)[16]) const {
        const int z = zz + b0 * 256; const int bhJ = z >> 1, eh = z & 1, b = bhJ >> 7, h = (bhJ >> 5) & 3, J = bhJ & 31, sidx = h * 2 + eh, i = rt * 32 + r;
        float ss = 0.f;
#pragma unroll
        for (int j = 0; j < 16; ++j) ss += v[j] * v[j];
        ss += __shfl_xor(ss, 1); ss += __shfl_xor(ss, 2); ss += __shfl_xor(ss, 4); ss += __shfl_xor(ss, 8);
        const int m = b * SEQ + J * 256 + i;
        if (tx < 4) SSQ[(size_t)m * 32 + h * 8 + eh * 4 + tx] = (tx == 0) ? ss : 0.f;
        bf16* p = OUT + ((size_t)sidx * SEQ + J * 256 + i) * 256;
#pragma unroll
        for (int j = 0; j < 16; ++j) p[tx + 16 * j] = f2bf(v[j]);
    }
};
__global__ void k_copy_u3(const bf16* __restrict__ TMP, bf16* __restrict__ YB, int b0) {
    const size_t idx = ((size_t)blockIdx.x * blockDim.x + threadIdx.x) * 8;
    const size_t sidx = idx / ((size_t)SEQ * 256), rem = idx % ((size_t)SEQ * 256);
    *(uint4*)(YB + (sidx * M_TOK + (size_t)b0 * SEQ) * 256 + rem) = *(const uint4*)(TMP + idx);
}
__global__ void k_copy16(const uint4* __restrict__ s, uint4* __restrict__ d) { const size_t i = (size_t)blockIdx.x * blockDim.x + threadIdx.x; d[i] = s[i]; }
struct F_G1A {
    const bf16* XB; const bf16* WIN; bf16* AIN; bf16* YA; bf16* SA; bf16* SB; bf16* YB;
    __device__ int nseg() const { return 1; }
    __device__ void seg(int z, int rt, int s, const bf16*& A, const bf16*& B, int& K, int& lda, int& ldb) const {
        int wrow; if (z < 4) wrow = 256 * z; else if (z < 8) wrow = 1024 + 256 * (z - 4); else if (z < 12) wrow = 8192 + 256 * (z - 8); else if (z < 16) wrow = 9216 + 256 * (z - 12); else wrow = 6144 + 256 * (z - 16);
        A = XB + (size_t)rt * 32 * DM; B = WIN + (size_t)wrow * DM; K = DM; lda = DM; ldb = DM; }
    __device__ void mid(int, int, int, int, int, float (&)[16]) const {}
    __device__ void store(int z, int rt, int r, int tx, float (&v)[16]) const {
        const int m = rt * 32 + r;
#pragma unroll
        for (int j = 0; j < 16; ++j) { const int c = tx + 16 * j;
            if (z < 4) AIN[(size_t)m * DM + z * 256 + c] = f2bf(v[j]);
            else if (z < 8) YA[((size_t)(z - 4) * M_TOK + m) * 256 + c] = f2bf(siluf(v[j]));
            else if (z < 12) SA[(size_t)m * DM + (z - 8) * 256 + c] = f2bf(sigmf(v[j]));
            else if (z < 16) SB[(size_t)m * DM + (z - 12) * 256 + c] = f2bf(sigmf(v[j]));
            else { bf16* p = YB + ((size_t)(z - 16) * M_TOK + m) * 256 + c; *p = f2bf(bf2f(*p) * siluf(v[j])); } }
    }
};
__global__ void k_pooled(const bf16* __restrict__ AIN, bf16* __restrict__ POOLED) {
    const int idx = blockIdx.x * blockDim.x + threadIdx.x;
    const int m = idx >> 7, c0 = (idx & 127) * 8, g = c0 >> 8, w = 2 << g, pos = m & 8191;
    const int cnt = (pos + 1 < w) ? pos + 1 : w;
    float s[8], self[8];
#pragma unroll
    for (int e = 0; e < 8; ++e) s[e] = 0.f;
    for (int t = 0; t < cnt; ++t) { const uint4 a = *(const uint4*)(AIN + (size_t)(m - t) * DM + c0); const unsigned ww[4] = {a.x, a.y, a.z, a.w};
#pragma unroll
        for (int e = 0; e < 4; ++e) { const float lo = __uint_as_float(ww[e] << 16), hi = __uint_as_float(ww[e] & 0xffff0000u); s[2 * e] += lo; s[2 * e + 1] += hi; if (t == 0) { self[2 * e] = lo; self[2 * e + 1] = hi; } } }
    const float inv = 1.f / (float)cnt;
    bf16 o[8];
#pragma unroll
    for (int e = 0; e < 8; ++e) o[e] = f2bf(s[e] * inv - self[e]);
    uint4 ov; ov.x = o[0] | ((unsigned)o[1] << 16); ov.y = o[2] | ((unsigned)o[3] << 16); ov.z = o[4] | ((unsigned)o[5] << 16); ov.w = o[6] | ((unsigned)o[7] << 16);
    *(uint4*)(POOLED + ((size_t)g * M_TOK + m) * 256 + (c0 & 255)) = ov;
}
struct F_POOL {
    const bf16* POOLED; const bf16* WPOOLT; bf16* YA;
    __device__ int nseg() const { return 1; }
    __device__ void seg(int z, int rt, int s, const bf16*& A, const bf16*& B, int& K, int& lda, int& ldb) const { A = POOLED + ((size_t)z * M_TOK + rt * 32) * 256; B = WPOOLT + (size_t)z * 65536; K = 256; lda = 256; ldb = 256; }
    __device__ void mid(int, int, int, int, int, float (&)[16]) const {}
    __device__ void store(int z, int rt, int r, int tx, float (&v)[16]) const {
        const int m = rt * 32 + r;
#pragma unroll
        for (int j = 0; j < 16; ++j) { bf16* p = YA + ((size_t)z * M_TOK + m) * 256 + tx + 16 * j; *p = f2bf(bf2f(*p) * v[j]); }
    }
};
struct F_G2 {
    const bf16* YA; const bf16* YB; const bf16* WAB; const bf16* SA; const bf16* SB; const float* SSQ; bf16* MERGED;
    __device__ int nseg() const { return 12; }
    __device__ void seg(int z, int rt, int s, const bf16*& A, const bf16*& B, int& K, int& lda, int& ldb) const {
        A = (s < 4 ? YA + ((size_t)s * M_TOK + rt * 32) * 256 : YB + ((size_t)(s - 4) * M_TOK + rt * 32) * 256); B = WAB + (size_t)s * 262144 + (size_t)z * 65536; K = 256; lda = 256; ldb = 256; }
    __device__ float rh(int m, int h) const { float t = 0.f; for (int q = 0; q < 8; ++q) t += SSQ[(size_t)m * 32 + h * 8 + q]; return 1.0f / sqrtf(t * (1.f / 512.f) + NORM_EPS); }
    __device__ void mid(int z, int rt, int s, int r, int tx, float (&v)[16]) const {
        const int m = rt * 32 + r;
        if (s == 3) { const float ir0 = 1.f / rh(m, 0);
#pragma unroll
            for (int j = 0; j < 16; ++j) { const int c = z * 256 + tx + 16 * j; v[j] *= bf2f(SA[(size_t)m * DM + c]) / bf2f(SB[(size_t)m * DM + c]) * ir0; } }
        else if (s == 5 || s == 7 || s == 9) { const int h = (s - 5) >> 1; const float f = rh(m, h) / rh(m, h + 1);
#pragma unroll
            for (int j = 0; j < 16; ++j) v[j] *= f; }
    }
    __device__ void store(int z, int rt, int r, int tx, float (&v)[16]) const {
        const int m = rt * 32 + r; const float r3 = rh(m, 3);
#pragma unroll
        for (int j = 0; j < 16; ++j) { const int c = z * 256 + tx + 16 * j; MERGED[(size_t)m * DM + c] = f2bf(v[j] * r3 * bf2f(SB[(size_t)m * DM + c])); }
    }
};
struct F_G3 {
    const bf16* MERGED; const bf16* WO; const float* X; float* OUT;
    __device__ int nseg() const { return 1; }
    __device__ void seg(int z, int rt, int s, const bf16*& A, const bf16*& B, int& K, int& lda, int& ldb) const { A = MERGED + (size_t)rt * 32 * DM; B = WO + (size_t)z * 256 * DM; K = DM; lda = DM; ldb = DM; }
    __device__ void mid(int, int, int, int, int, float (&)[16]) const {}
    __device__ void store(int z, int rt, int r, int tx, float (&v)[16]) const {
        const int m = rt * 32 + r;
#pragma unroll
        for (int j = 0; j < 16; ++j) { const size_t o = (size_t)m * DM + z * 256 + tx + 16 * j; OUT[o] = X[o] + v[j]; }
    }
};
__global__ void k_final_norm(float* __restrict__ out, const float* __restrict__ g) {
    const int row = blockIdx.x * 4 + (threadIdx.x >> 6), lane = threadIdx.x & 63;
    float4* xr = (float4*)(out + (size_t)row * DM);
    float4 v[4]; float s = 0.f;
#pragma unroll
    for (int j = 0; j < 4; ++j) { v[j] = xr[lane + 64 * j]; s += v[j].x * v[j].x + v[j].y * v[j].y + v[j].z * v[j].z + v[j].w * v[j].w; }
#pragma unroll
    for (int o = 1; o < 64; o <<= 1) s += __shfl_xor(s, o);
    const float rstd = 1.0f / sqrtf(s * (1.f / DM) + NORM_EPS);
#pragma unroll
    for (int j = 0; j < 4; ++j) { const float4 gg = ((const float4*)g)[lane + 64 * j]; float4 o; o.x = v[j].x * rstd * gg.x; o.y = v[j].y * rstd * gg.y; o.z = v[j].z * rstd * gg.z; o.w = v[j].w * rstd * gg.w; xr[lane + 64 * j] = o; }
}

extern "C" void kernel_launch(void* const* d_in, const int* in_sizes, int n_in, void* d_out, int out_size, void* d_ws, size_t ws_size, hipStream_t stream) {
    const float* x = (const float*)d_in[0]; const float* norm_in = (const float*)d_in[1]; const float* w_in = (const float*)d_in[2]; const float* w_pool = (const float*)d_in[3];
    const float* pool_scale = (const float*)d_in[4]; const float* w_a = (const float*)d_in[5]; const float* w_b = (const float*)d_in[6]; const float* w_o = (const float*)d_in[7]; const float* norm_out = (const float*)d_in[8];
    char* ws = (char*)d_ws; float* out = (float*)d_out;
    bf16* XB = (bf16*)(ws + WS_XB); bf16* WIN = (bf16*)(ws + WS_WIN); bf16* WAB = (bf16*)(ws + WS_WAB); bf16* WO = (bf16*)(ws + WS_WO); bf16* WPOOLT = (bf16*)(ws + WS_WPOOLT);
    h2_t* TABPF = (h2_t*)(ws + WS_TABPF); h2_t* TABFP = (h2_t*)(ws + WS_TABFP);
    bf16* Q = (bf16*)(ws + WS_Q); bf16* KN = (bf16*)(ws + WS_KN); bf16* PB = KN; bf16* KZT = (bf16*)(ws + WS_KZT); bf16* WSB = (bf16*)(ws + WS_WS); bf16* VT = (bf16*)d_out; bf16* YB = VT;
    float* SSQ = (float*)(ws + WS_SSQ);
    bf16* AIN = (bf16*)(ws + WS_AIN); bf16* YA = (bf16*)(ws + WS_YA); bf16* SA = (bf16*)(ws + WS_SA); bf16* SB = (bf16*)(ws + WS_SB); bf16* POOLED = (bf16*)(ws + WS_POOLED); bf16* MERGED = (bf16*)(ws + WS_MERGED);
    k_prep_x<<<M_TOK / 4, 256, 0, stream>>>(x, norm_in, XB);
    k_transpose<<<dim3(DIN / 32, DM / 32), 256, 0, stream>>>(w_in, DM, DIN, WIN, DM, nullptr);
    for (int s = 0; s < 4; ++s) k_transpose<<<dim3(32, 8), 256, 0, stream>>>(w_a + (size_t)s * 256 * DM, 256, DM, WAB + (size_t)s * 262144, 256, nullptr);
    for (int s = 0; s < 8; ++s) k_transpose<<<dim3(32, 8), 256, 0, stream>>>(w_b + (size_t)s * 256 * DM, 256, DM, WAB + (size_t)(4 + s) * 262144, 256, nullptr);
    for (int g = 0; g < 4; ++g) k_transpose<<<dim3(8, 8), 256, 0, stream>>>(w_pool + (size_t)g * 65536, 256, 256, WPOOLT + (size_t)g * 65536, 256, pool_scale + g * 256);
    k_transpose<<<dim3(32, 32), 256, 0, stream>>>(w_o, DM, DM, WO, DM, nullptr);
    k_tables<<<SEQ * 128 / 256, 256, 0, stream>>>(TABPF, TABFP);
    { F_G1R f{XB, WIN, TABPF, Q, KN, KZT, VT}; k_gemm<F_G1R><<<dim3(M_TOK / 32, 20), 256, 0, stream>>>(f); }
    { F_U1 f{Q, KN, WSB}; k_gemm<F_U1><<<dim3(8, 256), 256, 0, stream>>>(f); k_copy16<<<(32 * MiB / 16) / 256, 256, 0, stream>>>((const uint4*)WSB, (uint4*)PB); }
    { F_U2 f{VT, KZT, WSB}; k_gemm<F_U2><<<dim3(8, 512), 256, 0, stream>>>(f); }
    k_prefix<<<8 * 131072 / 256, 256, 0, stream>>>(WSB);
    for (int b0 = 0; b0 < 2; ++b0) { F_U3 f{Q, WSB, PB, VT, KZT, SSQ, b0}; k_gemm<F_U3><<<dim3(8, 256), 256, 0, stream>>>(f); k_copy_u3<<<(8 * SEQ * 256 / 8) / 256, 256, 0, stream>>>(KZT, YB, b0); }
    { F_G1A f{XB, WIN, AIN, YA, SA, SB, YB}; k_gemm<F_G1A><<<dim3(M_TOK / 32, 24), 256, 0, stream>>>(f); }
    k_pooled<<<M_TOK * 128 / 256, 256, 0, stream>>>(AIN, POOLED);
    { F_POOL f{POOLED, WPOOLT, YA}; k_gemm<F_POOL><<<dim3(M_TOK / 32, 4), 256, 0, stream>>>(f); }
    { F_G2 f{YA, YB, WAB, SA, SB, SSQ, MERGED}; k_gemm<F_G2><<<dim3(M_TOK / 32, 4), 256, 0, stream>>>(f); }
    { F_G3 f{MERGED, WO, x, out}; k_gemm<F_G3><<<dim3(M_TOK / 32, 4), 256, 0, stream>>>(f); }
    k_final_norm<<<M_TOK / 4, 256, 0, stream>>>(out, norm_out);
}
```

```cpp
#include <hip/hip_runtime.h>
#include <stdint.h>
#include <cstdio>

#ifndef MK_N_LAUNCHES
#define MK_N_LAUNCHES 1
#endif
constexpr int N_PHASES = 11;
constexpr int N_LAUNCHES = MK_N_LAUNCHES;

#define LAS __attribute__((address_space(3)))
#define GAS __attribute__((address_space(1)))
typedef unsigned short bf16;
typedef _Float16 h2_t __attribute__((ext_vector_type(2)));
typedef short bf16x8 __attribute__((ext_vector_type(8)));
typedef float f32x4 __attribute__((ext_vector_type(4)));
typedef unsigned u32x4 __attribute__((ext_vector_type(4)));
typedef unsigned u32x2 __attribute__((ext_vector_type(2)));

constexpr int M_TOK = 16384, SEQ = 8192, DM = 1024, DIN = 10240;
constexpr float NORM_EPS = 1e-6f;
constexpr size_t MiB = 1u << 20;
constexpr size_t WS_CTL = 0, CTL_ZERO_BYTES = 1 * MiB, WS_SSQ = 1 * MiB, WS_WPOOLT = 3 * MiB, WS_WAB = 4 * MiB, WS_WO = 10 * MiB, WS_TABPF = 12 * MiB, WS_TABFP = 16 * MiB,
                 WS_WIN = 20 * MiB, WS_XB = 40 * MiB, WS_Q = 72 * MiB, WS_KN = 104 * MiB, WS_KZT = 136 * MiB, WS_WS = 168 * MiB;
constexpr size_t WS_AIN = 72 * MiB, WS_YA = 104 * MiB, WS_SA = 136 * MiB, WS_SB = 168 * MiB, WS_POOLED = 200 * MiB, WS_MERGED = 40 * MiB;
constexpr int CW_BAR = 4096;
constexpr int RING_BYTES = 131072, LDSCTL_OFF = RING_BYTES, MISC_OFF = LDSCTL_OFF + 320, LDS_BYTES = 147456;
constexpr int NWAVES = 8;

__device__ __forceinline__ float lg2gamma(int h) { return h == 0 ? -0.04580368961312479f : h == 1 ? -0.02272007650008353f : h == 2 ? -0.011315313227834146f : -0.005646563141142063f; }
__device__ __forceinline__ float siluf(float x) { return x * __builtin_amdgcn_rcpf(1.f + __expf(-x)); }
__device__ __forceinline__ float sigmf(float x) { return __builtin_amdgcn_rcpf(1.f + __expf(-x)); }
typedef float f32x2_t __attribute__((ext_vector_type(2)));
typedef __bf16 bf16x2_t __attribute__((ext_vector_type(2)));
__device__ __forceinline__ unsigned cvt_pk_bf16(float lo, float hi) { const f32x2_t v = {lo, hi}; const bf16x2_t b = __builtin_convertvector(v, bf16x2_t); return __builtin_bit_cast(unsigned, b); }
__device__ __forceinline__ u32x4 pack8(const f32x4 a, const f32x4 b) { u32x4 w; w.x = cvt_pk_bf16(a[0], a[1]); w.y = cvt_pk_bf16(a[2], a[3]); w.z = cvt_pk_bf16(b[0], b[1]); w.w = cvt_pk_bf16(b[2], b[3]); return w; }
__device__ __forceinline__ void unpack8(const u32x4 w, f32x4& a, f32x4& b) {
    a[0] = __uint_as_float(w.x << 16); a[1] = __uint_as_float(w.x & 0xffff0000u); a[2] = __uint_as_float(w.y << 16); a[3] = __uint_as_float(w.y & 0xffff0000u);
    b[0] = __uint_as_float(w.z << 16); b[1] = __uint_as_float(w.z & 0xffff0000u); b[2] = __uint_as_float(w.w << 16); b[3] = __uint_as_float(w.w & 0xffff0000u); }
__device__ __forceinline__ void h2unpack(unsigned w, float& c, float& s) { const h2_t v = __builtin_bit_cast(h2_t, w); c = (float)v.x; s = (float)v.y; }

namespace pg8 {
constexpr int BM = 256, BK = 64, HALF = 128, HTB = HALF * BK * 2, NXCD = 8, WGM = 8;
__host__ __device__ __forceinline__ int lds_byte(int r, int c) { const int st = (r >> 4) * 2 + (c >> 5), rr = r & 15, cc = c & 31, ob = rr * 64 + cc * 2; return st * 1024 + (ob ^ (((ob >> 9) & 1) << 5)); }
__host__ __device__ __forceinline__ void stage_rc(int b, int& R, int& C) { const int st = b / 1024, sb = b % 1024, swz = sb ^ (((sb >> 9) & 1) << 5); R = (st >> 1) * 16 + swz / 64; C = (st & 1) * 32 + (swz % 64) / 2; }
__host__ __device__ __forceinline__ int perm32(int rho) { const int n = rho >> 4, i = rho & 15; return 8 * (i >> 2) + 4 * n + (i & 3); }

struct Seg { const char* A; const char* B; int nt; int kind; int pm; int pn; int seg; };

struct TileOrder {
    int nM, nN, nwg, G, c;
    __device__ void init(int nM_, int nN_, int G_, int c_) { nM = nM_; nN = nN_; nwg = nM * nN; G = G_; c = c_; }
    __device__ bool tile(int i, int& pm, int& pn) const {
        const long L = (long)i * G + c; if (L >= nwg) return false;
        int wgid = (int)L; { const int q = nwg / NXCD, r = nwg % NXCD, xcd = wgid % NXCD, off = wgid / NXCD; wgid = (xcd < r ? xcd * (q + 1) : r * (q + 1) + (xcd - r) * q) + off; }
        const int nig = WGM * nN, gid = wgid / nig, fm = gid * WGM, gsz = (nM - fm) < WGM ? (nM - fm) : WGM;
        pm = fm + ((wgid % nig) % gsz); pn = (wgid % nig) / gsz; return true;
    }
};

template <class Epi, class Sched, bool ALIGN_EPI>
__device__ __forceinline__ void gemm_phase(LAS unsigned char* lds, const int ld, const Sched& S, const Epi& E) {
    const int tid = threadIdx.x, wid = __builtin_amdgcn_readfirstlane(tid >> 6), lane = tid & 63, wr = wid >> 2, wc = wid & 3, fr = lane & 15, fq = lane >> 4;
    unsigned voffA[2], voffB[2];
#pragma unroll
    for (int i = 0; i < 2; ++i) { int R, C; stage_rc(tid * 16 + i * 8192, R, C); const int Rb = Epi::PERM ? ((R & ~31) + perm32(R & 31)) : R;
        voffA[i] = (unsigned)(R * ld + C) * 2u; voffB[i] = (unsigned)(Rb * ld + C) * 2u; }
    const size_t kstep = (size_t)(BK * 2);
    const size_t hstep = (size_t)HALF * ld * 2;
    const unsigned ldsw = (unsigned)wid * 1024u;
    const int aoff = lds_byte(wr * 64 + fr, fq * 8), boff = lds_byte(wc * 32 + fr, fq * 8);
#define PG8_SA(b, h) (((b) * 2 + (h)) * HTB)
#define PG8_SB(b, h) ((4 + (b) * 2 + (h)) * HTB)
#define PG8_STAGE(bufoff, gbase, voff) do { _Pragma("unroll") for (int _i = 0; _i < 2; ++_i) \
        __builtin_amdgcn_global_load_lds((const unsigned*)((const char*)(gbase) + (voff)[_i]), (LAS unsigned*)(lds + (bufoff) + ldsw + _i * 8192), 16, 0, 0); } while (0)
#define PG8_LDA(dst, b, h) do { _Pragma("unroll") for (int m = 0; m < 4; ++m) _Pragma("unroll") for (int k = 0; k < 2; ++k) dst[m][k] = *(const LAS bf16x8*)(lds + PG8_SA(b, h) + aoff + m * 2048 + k * 1024); } while (0)
#define PG8_LDB(dst, b, h) do { _Pragma("unroll") for (int n = 0; n < 2; ++n) _Pragma("unroll") for (int k = 0; k < 2; ++k) dst[n][k] = *(const LAS bf16x8*)(lds + PG8_SB(b, h) + boff + n * 2048 + k * 1024); } while (0)
#define PG8_MMA(ai, bj, At, Bt) do { __builtin_amdgcn_s_setprio(1); _Pragma("unroll") for (int m = 0; m < 4; ++m) _Pragma("unroll") for (int n = 0; n < 2; ++n) _Pragma("unroll") for (int k = 0; k < 2; ++k) \
        acc[ai][bj][m][n] = __builtin_amdgcn_mfma_f32_16x16x32_bf16(Bt[n][k], At[m][k], acc[ai][bj][m][n], 0, 0, 0); __builtin_amdgcn_s_setprio(0); } while (0)
#define PG8_WAIT_V(n) asm volatile("s_waitcnt vmcnt(" #n ")" ::: "memory")
#define PG8_WAIT_L(n) asm volatile("s_waitcnt lgkmcnt(" #n ")" ::: "memory")
#define PG8_BAR __builtin_amdgcn_s_barrier()
#define PG8_SCHED __builtin_amdgcn_sched_barrier(0)
    Seg cur, nxt; int si = 0;
    if (!S.next(0, cur)) return;
    f32x4 acc[2][2][4][2];
#pragma unroll
    for (int a = 0; a < 2; ++a)
#pragma unroll
        for (int b = 0; b < 2; ++b)
#pragma unroll
            for (int m = 0; m < 4; ++m)
#pragma unroll
                for (int n = 0; n < 2; ++n) acc[a][b][m][n] = (f32x4){0.f, 0.f, 0.f, 0.f};
    bf16x8 At[4][2], B0[2][2], B1[2][2];
    const char* cA = cur.A; const char* cB = cur.B;
    PG8_STAGE(PG8_SB(0, 0), cB, voffB); PG8_STAGE(PG8_SB(0, 1), cB + hstep, voffB); PG8_STAGE(PG8_SA(0, 0), cA, voffA); PG8_STAGE(PG8_SA(0, 1), cA + hstep, voffA);
    if (wr == 1) PG8_BAR;
    PG8_WAIT_V(2); PG8_BAR;
    PG8_STAGE(PG8_SB(1, 0), cB + kstep, voffB); PG8_STAGE(PG8_SA(1, 0), cA + kstep, voffA); PG8_STAGE(PG8_SB(1, 1), cB + hstep + kstep, voffB);
    PG8_WAIT_V(6); PG8_BAR;
    for (;;) {
        const bool has_next = S.next(si + 1, nxt);
        const char* nA = has_next ? nxt.A : cA; const char* nB = has_next ? nxt.B : cB;
        const int nt = cur.nt;
        for (int t = 0; t < nt; t += 2) {
            const bool last = (t == nt - 2);
            const char* a1 = cA + (size_t)(t + 1) * kstep;
            const char* a2 = last ? nA : cA + (size_t)(t + 2) * kstep; const char* b2 = last ? nB : cB + (size_t)(t + 2) * kstep;
            const char* a3 = a2 + kstep; const char* b3 = b2 + kstep;
            PG8_LDB(B0, 0, 0); PG8_LDB(B1, 0, 1); PG8_SCHED; PG8_LDA(At, 0, 0); PG8_STAGE(PG8_SA(1, 1), a1 + hstep, voffA);
            PG8_WAIT_V(8); PG8_WAIT_L(0); PG8_BAR; PG8_MMA(0, 0, At, B0); PG8_MMA(0, 1, At, B1); PG8_BAR; PG8_SCHED;
            PG8_LDA(At, 0, 1); PG8_STAGE(PG8_SB(0, 0), b2, voffB); PG8_STAGE(PG8_SB(0, 1), b2 + hstep, voffB); PG8_STAGE(PG8_SA(0, 0), a2, voffA);
            PG8_WAIT_V(8); PG8_WAIT_L(0); PG8_BAR; PG8_MMA(1, 0, At, B0); PG8_MMA(1, 1, At, B1); PG8_BAR; PG8_SCHED;
            PG8_LDB(B0, 1, 0); PG8_LDB(B1, 1, 1); PG8_SCHED; PG8_LDA(At, 1, 0); PG8_STAGE(PG8_SA(0, 1), a2 + hstep, voffA);
            PG8_WAIT_V(8); PG8_WAIT_L(0); PG8_BAR; PG8_MMA(0, 0, At, B0); PG8_MMA(0, 1, At, B1); PG8_BAR; PG8_SCHED;
            PG8_LDA(At, 1, 1); PG8_STAGE(PG8_SB(1, 0), b3, voffB); PG8_STAGE(PG8_SB(1, 1), b3 + hstep, voffB); PG8_STAGE(PG8_SA(1, 0), a3, voffA);
            PG8_WAIT_V(8); PG8_WAIT_L(0); PG8_BAR; PG8_MMA(1, 0, At, B0); PG8_MMA(1, 1, At, B1); PG8_BAR; PG8_SCHED;
        }
        if constexpr (ALIGN_EPI) { if (wr == 0) PG8_BAR; }
        const bool zero = E(acc, cur, wr, wc, fr, fq);
        if (!has_next) break;
        if (zero) {
#pragma unroll
            for (int a = 0; a < 2; ++a)
#pragma unroll
                for (int b = 0; b < 2; ++b)
#pragma unroll
                    for (int m = 0; m < 4; ++m)
#pragma unroll
                        for (int n = 0; n < 2; ++n) acc[a][b][m][n] = (f32x4){0.f, 0.f, 0.f, 0.f};
        }
        cur = nxt; cA = nA; cB = nB; ++si;
        if constexpr (ALIGN_EPI) { if (wr == 1) PG8_BAR; }
    }
    PG8_WAIT_V(0);
    if constexpr (!ALIGN_EPI) { if (wr == 0) PG8_BAR; }
    PG8_BAR;
#undef PG8_SA
#undef PG8_SB
#undef PG8_STAGE
#undef PG8_LDA
#undef PG8_LDB
#undef PG8_MMA
#undef PG8_WAIT_V
#undef PG8_WAIT_L
#undef PG8_BAR
#undef PG8_SCHED
}
}
using pg8::Seg;

#define FOR_AI_M _Pragma("unroll") for (int ai = 0; ai < 2; ++ai) _Pragma("unroll") for (int m = 0; m < 4; ++m)
#define FOR_BJ _Pragma("unroll") for (int bj = 0; bj < 2; ++bj)
typedef f32x4 acc_t[2][2][4][2];
#define EPI_FENCE asm volatile("" ::: "memory")

struct SchedG1 {
    pg8::TileOrder T; const char* XB; const char* WIN; int phase;
    __device__ bool next(int i, Seg& s) const {
        int pm, pn; if (!T.tile(i, pm, pn)) return false;
        int wrow; bool tr = false;
        if (phase == 0) { if (pn < 4) wrow = 2048 + 256 * pn; else if (pn < 8) wrow = 3072 + 256 * (pn - 4); else if (pn < 12) { wrow = 3072 + 256 * (pn - 8); tr = true; } else { wrow = 4096 + 256 * (pn - 12); tr = true; } }
        else { if (pn < 4) wrow = 256 * pn; else if (pn < 8) wrow = 1024 + 256 * (pn - 4); else if (pn < 12) wrow = 8192 + 256 * (pn - 8); else if (pn < 16) wrow = 9216 + 256 * (pn - 12); else wrow = 6144 + 256 * (pn - 16); }
        const char* xp = XB + (size_t)pm * 256 * DM * 2; const char* wp = WIN + (size_t)wrow * DM * 2;
        s.A = tr ? wp : xp; s.B = tr ? xp : wp; s.nt = DM / 64; s.kind = 0; s.pm = pm; s.pn = pn; s.seg = 0; return true;
    }
};
struct EpiG1R {
    static constexpr bool PERM = true;
    const h2_t* TABPF; const h2_t* TABFP; bf16* Q; bf16* KN; bf16* KZT; bf16* VT;
    __device__ __forceinline__ bool operator()(acc_t& acc, const Seg& sg, int wr, int wc, int fr, int fq) const {
        asm volatile("" : "+v"(fr), "+v"(fq));
        const int pm = sg.pm, t = sg.pn, b = pm >> 5, J = pm & 31;
        if (t < 8) {
            const int h = t & 3, bh = b * 4 + h; const float sc = (t < 4) ? 0.0625f : 1.0f;
            bf16* dst = (t < 4 ? Q : KN) + ((size_t)bh * SEQ + J * 256) * 256;
            const int f8 = wc * 32 + fq * 8;
            FOR_AI_M { const int r = ai * 128 + wr * 64 + m * 16 + fr, pos = J * 256 + r;
                const u32x4 t0 = *(const u32x4*)(TABPF + (size_t)pos * 128 + f8), t1 = *(const u32x4*)(TABPF + (size_t)pos * 128 + f8 + 4);
                f32x4 o1[2], o2[2];
#pragma unroll
                for (int n = 0; n < 2; ++n) { const u32x4 tt = n ? t1 : t0; const f32x4 lo = acc[ai][0][m][n], hi = acc[ai][1][m][n];
#pragma unroll
                    for (int j = 0; j < 4; ++j) { float c, s; h2unpack(tt[j], c, s); o1[n][j] = (lo[j] * c - hi[j] * s) * sc; o2[n][j] = (lo[j] * s + hi[j] * c) * sc; } }
                *(u32x4*)(dst + (size_t)r * 256 + f8) = pack8(o1[0], o1[1]); *(u32x4*)(dst + (size_t)r * 256 + f8 + 128) = pack8(o2[0], o2[1]); EPI_FENCE; }
        } else if (t < 12) {
            const int h = (t - 8) & 3, bhJ = (b * 4 + h) * 32 + J; const float lg = lg2gamma(h);
            bf16* dst = KZT + (size_t)bhJ * 65536;
            FOR_BJ { const int c8 = bj * 128 + wc * 32 + fq * 8;
                float z[8];
#pragma unroll
                for (int j = 0; j < 8; ++j) z[j] = __builtin_amdgcn_exp2f((float)(255 - c8 - j) * lg);
#pragma unroll
                for (int m = 0; m < 4; ++m) { const int d = wr * 64 + m * 16 + fr;
                    const h2_t* tp = TABFP + (size_t)d * SEQ + J * 256 + c8; const u32x4 t0 = *(const u32x4*)tp, t1 = *(const u32x4*)(tp + 4);
                    f32x4 o1[2], o2[2];
#pragma unroll
                    for (int n = 0; n < 2; ++n) { const u32x4 tt = n ? t1 : t0; const f32x4 lo = acc[0][bj][m][n], hi = acc[1][bj][m][n];
#pragma unroll
                        for (int j = 0; j < 4; ++j) { float c, s; h2unpack(tt[j], c, s); o1[n][j] = (lo[j] * c - hi[j] * s) * z[n * 4 + j]; o2[n][j] = (lo[j] * s + hi[j] * c) * z[n * 4 + j]; } }
                    *(u32x4*)(dst + (size_t)d * 256 + c8) = pack8(o1[0], o1[1]); *(u32x4*)(dst + (size_t)(d + 128) * 256 + c8) = pack8(o2[0], o2[1]); EPI_FENCE; } }
        } else {
            const int sidx = t - 12; bf16* dst = VT + ((size_t)sidx * M_TOK + b * SEQ + J * 256) * 256;
            FOR_AI_M { const int r = ai * 128 + wr * 64 + m * 16 + fr;
                FOR_BJ { const int c8 = bj * 128 + wc * 32 + fq * 8; *(u32x4*)(dst + (size_t)r * 256 + c8) = pack8(acc[ai][bj][m][0], acc[ai][bj][m][1]); } }
        }
        return true;
    }
};
struct SchedU12 {
    int G, c; const char* Q; const char* KN; const char* VT; const char* KZT;
    __device__ bool next(int i, Seg& s) const {
        const int u = i * G + c; if (u >= 768) return false;
        s.nt = 4; s.seg = 0;
        if (u < 256) { s.kind = 0; s.pm = u; s.pn = 0; s.A = Q + (size_t)u * 131072; s.B = KN + (size_t)u * 131072; }
        else { const int v = u - 256, bhJ = v >> 1, eh = v & 1, b = bhJ >> 7, h = (bhJ >> 5) & 3, J = bhJ & 31, sidx = h * 2 + eh;
            s.kind = 1; s.pm = bhJ; s.pn = eh; s.A = VT + ((size_t)sidx * M_TOK + b * SEQ + J * 256) * 512; s.B = KZT + (size_t)bhJ * 131072; }
        return true;
    }
};
struct EpiU12 {
    static constexpr bool PERM = true;
    bf16* PB; bf16* WS;
    __device__ __forceinline__ bool operator()(acc_t& acc, const Seg& sg, int wr, int wc, int fr, int fq) const {
        asm volatile("" : "+v"(fr), "+v"(fq));
        if (sg.kind == 0) {
            const int bhJ = sg.pm, h = (bhJ >> 5) & 3; const float lg = lg2gamma(h); bf16* dst = PB + (size_t)bhJ * 65536;
            FOR_AI_M { const int i = ai * 128 + wr * 64 + m * 16 + fr;
                FOR_BJ { const int c8 = bj * 128 + wc * 32 + fq * 8; f32x4 o[2];
#pragma unroll
                    for (int n = 0; n < 2; ++n)
#pragma unroll
                        for (int j = 0; j < 4; ++j) { const int jj = c8 + n * 4 + j, dd = i > jj ? i - jj : jj - i; const float w = ((jj >> 6) <= (i >> 6)) ? __builtin_amdgcn_exp2f((float)dd * lg) : 0.f; o[n][j] = acc[ai][bj][m][n][j] * w; }
                    *(u32x4*)(dst + (size_t)i * 256 + c8) = pack8(o[0], o[1]); EPI_FENCE; } }
        } else {
            bf16* dst = WS + (size_t)sg.pm * 131072 + (size_t)sg.pn * 65536;
            FOR_AI_M { const int r = ai * 128 + wr * 64 + m * 16 + fr;
                FOR_BJ { const int c8 = bj * 128 + wc * 32 + fq * 8; *(u32x4*)(dst + (size_t)r * 256 + c8) = pack8(acc[ai][bj][m][0], acc[ai][bj][m][1]); } }
        }
        return true;
    }
};
struct SchedU3 {
    int G, c; const char* Q; const char* WS; const char* PB; const char* VT;
    __device__ bool next(int si, Seg& s) const {
        const int u = (si >> 1) * G + c, sg = si & 1; if (u >= 512) return false;
        const int bhJ = u >> 1, eh = u & 1, b = bhJ >> 7, h = (bhJ >> 5) & 3, J = bhJ & 31, sidx = h * 2 + eh;
        s.nt = 4; s.seg = sg; s.kind = 0; s.pm = bhJ; s.pn = eh;
        if (sg == 0) { s.A = Q + (size_t)bhJ * 131072; s.B = WS + (size_t)bhJ * 262144 + (size_t)eh * 131072; }
        else { s.A = PB + (size_t)bhJ * 131072; s.B = VT + ((size_t)sidx * M_TOK + b * SEQ + J * 256) * 512; }
        return true;
    }
};
struct EpiU3 {
    static constexpr bool PERM = true;
    bf16* YB; float* SSQ;
    __device__ __forceinline__ bool operator()(acc_t& acc, const Seg& sg, int wr, int wc, int fr, int fq) const {
        asm volatile("" : "+v"(fr), "+v"(fq));
        const int bhJ = sg.pm, eh = sg.pn, b = bhJ >> 7, h = (bhJ >> 5) & 3, J = bhJ & 31, sidx = h * 2 + eh;
        if (sg.seg == 0) {
            const float lg = lg2gamma(h);
            FOR_AI_M { const int i = ai * 128 + wr * 64 + m * 16 + fr; const float w = __builtin_amdgcn_exp2f((float)(i + 1) * lg);
                FOR_BJ { acc[ai][bj][m][0] *= w; acc[ai][bj][m][1] *= w; } }
            return false;
        }
        bf16* dst = YB + ((size_t)sidx * M_TOK + b * SEQ + J * 256) * 256;
        FOR_AI_M { const int i = ai * 128 + wr * 64 + m * 16 + fr; float ss = 0.f;
            FOR_BJ { const int c8 = bj * 128 + wc * 32 + fq * 8; const f32x4 v0 = acc[ai][bj][m][0], v1 = acc[ai][bj][m][1];
                ss += (v0[0] * v0[0] + v0[1] * v0[1]) + (v0[2] * v0[2] + v0[3] * v0[3]) + (v1[0] * v1[0] + v1[1] * v1[1]) + (v1[2] * v1[2] + v1[3] * v1[3]);
                *(u32x4*)(dst + (size_t)i * 256 + c8) = pack8(v0, v1); }
            ss += __shfl_xor(ss, 16); ss += __shfl_xor(ss, 32);
            if (fq == 0) SSQ[(size_t)(b * SEQ + J * 256 + i) * 32 + h * 8 + eh * 4 + wc] = ss; EPI_FENCE; }
        return true;
    }
};
struct EpiG1A {
    static constexpr bool PERM = true;
    bf16* AIN; bf16* YA; bf16* SA; bf16* SB; bf16* YB; const float* SSQ;
    __device__ __forceinline__ bool operator()(acc_t& acc, const Seg& sg, int wr, int wc, int fr, int fq) const {
        asm volatile("" : "+v"(fr), "+v"(fq));
        const int t = sg.pn; const size_t m0 = (size_t)sg.pm * 256;
        FOR_AI_M { const size_t mm = m0 + ai * 128 + wr * 64 + m * 16 + fr; float rn = 1.f;
            if (t >= 16) { const float* sp = SSQ + mm * 32 + ((t - 16) >> 1) * 8; const f32x4 a = *(const f32x4*)sp, b = *(const f32x4*)(sp + 4); rn = 1.0f / sqrtf((((a[0] + a[1]) + (a[2] + a[3])) + ((b[0] + b[1]) + (b[2] + b[3]))) * (1.f / 512.f) + NORM_EPS); }
            FOR_BJ { const int c8 = bj * 128 + wc * 32 + fq * 8; f32x4 v0 = acc[ai][bj][m][0], v1 = acc[ai][bj][m][1];
                if (t < 4) { *(u32x4*)(AIN + mm * DM + t * 256 + c8) = pack8(v0, v1); }
                else if (t < 8) {
#pragma unroll
                    for (int j = 0; j < 4; ++j) { v0[j] = siluf(v0[j]); v1[j] = siluf(v1[j]); }
                    *(u32x4*)(YA + ((size_t)(t - 4) * M_TOK + mm) * 256 + c8) = pack8(v0, v1); }
                else if (t < 16) {
#pragma unroll
                    for (int j = 0; j < 4; ++j) { v0[j] = sigmf(v0[j]); v1[j] = sigmf(v1[j]); }
                    *(u32x4*)((t < 12 ? SA : SB) + mm * DM + ((t - 8) & 3) * 256 + c8) = pack8(v0, v1); }
                else { bf16* p = YB + ((size_t)(t - 16) * M_TOK + mm) * 256 + c8; f32x4 y0, y1; unpack8(*(const u32x4*)p, y0, y1);
#pragma unroll
                    for (int j = 0; j < 4; ++j) { v0[j] = y0[j] * rn * siluf(v0[j]); v1[j] = y1[j] * rn * siluf(v1[j]); }
                    *(u32x4*)p = pack8(v0, v1); } } EPI_FENCE; }
        return true;
    }
};
struct SchedPool {
    pg8::TileOrder T; const char* POOLED; const char* WPOOLT;
    __device__ bool next(int i, Seg& s) const { int pm, pn; if (!T.tile(i, pm, pn)) return false;
        s.A = POOLED + ((size_t)pn * M_TOK + (size_t)pm * 256) * 512; s.B = WPOOLT + (size_t)pn * 131072; s.nt = 4; s.kind = 0; s.pm = pm; s.pn = pn; s.seg = 0; return true; }
};
struct EpiPool {
    static constexpr bool PERM = true;
    bf16* YA;
    __device__ __forceinline__ bool operator()(acc_t& acc, const Seg& sg, int wr, int wc, int fr, int fq) const {
        asm volatile("" : "+v"(fr), "+v"(fq));
        bf16* base = YA + ((size_t)sg.pn * M_TOK + (size_t)sg.pm * 256) * 256;
        FOR_AI_M { const int r = ai * 128 + wr * 64 + m * 16 + fr;
            FOR_BJ { const int c8 = bj * 128 + wc * 32 + fq * 8; bf16* p = base + (size_t)r * 256 + c8; f32x4 y0, y1; unpack8(*(const u32x4*)p, y0, y1);
                *(u32x4*)p = pack8(y0 * acc[ai][bj][m][0], y1 * acc[ai][bj][m][1]); } EPI_FENCE; }
        return true;
    }
};
struct SchedG2 {
    pg8::TileOrder T; const char* YA; const char* YB; const char* WAB;
    __device__ bool next(int si, Seg& s) const { const int ui = si / 12, sg = si - ui * 12; int pm, pn; if (!T.tile(ui, pm, pn)) return false;
        s.A = (sg < 4 ? YA + ((size_t)sg * M_TOK + (size_t)pm * 256) * 512 : YB + ((size_t)(sg - 4) * M_TOK + (size_t)pm * 256) * 512);
        s.B = WAB + (size_t)sg * 524288 + (size_t)pn * 131072; s.nt = 4; s.kind = 0; s.pm = pm; s.pn = pn; s.seg = sg; return true; }
};
struct EpiG2 {
    static constexpr bool PERM = true;
    const bf16* SA; const bf16* SB; bf16* MERGED;
    __device__ __forceinline__ bool operator()(acc_t& acc, const Seg& sg, int wr, int wc, int fr, int fq) const {
        asm volatile("" : "+v"(fr), "+v"(fq));
        const int s = sg.seg; const size_t m0 = (size_t)sg.pm * 256; const int cb = sg.pn * 256;
        if (s == 3 || s == 11) {
            const bool fin = (s == 11); const bf16* GT = fin ? SB : SA;
            FOR_AI_M { const int r = ai * 128 + wr * 64 + m * 16 + fr; const size_t mm = m0 + r;
                FOR_BJ { const int c8 = cb + bj * 128 + wc * 32 + fq * 8; f32x4 g0, g1, t0, t1; unpack8(*(const u32x4*)(GT + mm * DM + c8), g0, g1); unpack8(*(const u32x4*)(MERGED + mm * DM + c8), t0, t1);
#pragma unroll
                    for (int j = 0; j < 4; ++j) { t0[j] = fin ? t0[j] : 0.f; t1[j] = fin ? t1[j] : 0.f; }
                    *(u32x4*)(MERGED + mm * DM + c8) = pack8(acc[ai][bj][m][0] * g0 + t0, acc[ai][bj][m][1] * g1 + t1); EPI_FENCE; } }
            return true;
        }
        return false;
    }
};
struct SchedG3 {
    pg8::TileOrder T; const char* MERGED; const char* WO;
    __device__ bool next(int i, Seg& s) const { int pm, pn; if (!T.tile(i, pm, pn)) return false;
        s.A = MERGED + (size_t)pm * 256 * DM * 2; s.B = WO + (size_t)pn * 256 * DM * 2; s.nt = DM / 64; s.kind = 0; s.pm = pm; s.pn = pn; s.seg = 0; return true; }
};
struct EpiG3 {
    static constexpr bool PERM = false;
    const float* X; float* OUT;
    __device__ __forceinline__ bool operator()(acc_t& acc, const Seg& sg, int wr, int wc, int fr, int fq) const {
        asm volatile("" : "+v"(fr), "+v"(fq));
        FOR_AI_M { const size_t mm = (size_t)sg.pm * 256 + ai * 128 + wr * 64 + m * 16 + fr;
            FOR_BJ {
#pragma unroll
                for (int n = 0; n < 2; ++n) { const size_t o = mm * DM + sg.pn * 256 + bj * 128 + wc * 32 + n * 16 + fq * 4; *(f32x4*)(OUT + o) = *(const f32x4*)(X + o) + acc[ai][bj][m][n]; } } }
        return true;
    }
};

#define XB_TMO      128
#define XB_XCNT(j)  (256  + 64 * (j))
#define XB_XSUB(j)  (1280 + 64 * (j))
#define XB_XGEN(j)  (2304 + 64 * (j))
#define XB_TOP      3328
#define XB_TOPGEN   3392
#define XCD_BAR_WORDS 3456
#define XB_SPIN_CAP (1u << 18)
__device__ __forceinline__ unsigned xb_ld(unsigned* p)              { return __hip_atomic_load(p, __ATOMIC_RELAXED, __HIP_MEMORY_SCOPE_AGENT); }
__device__ __forceinline__ unsigned xb_add(unsigned* p, unsigned v) { return __hip_atomic_fetch_add(p, v, __ATOMIC_RELAXED, __HIP_MEMORY_SCOPE_AGENT); }
__device__ __forceinline__ unsigned xb_xcc_id() { return (unsigned)__builtin_amdgcn_s_getreg((3 << 11) | 20) & 0xFu; }
#define XB_SPIN(cond, bar) do { unsigned _sp = 0; while (cond) { __builtin_amdgcn_s_sleep(1); \
    if ((++_sp & 255u) == 0u) { if (xb_ld(&(bar)[XB_TMO])) break; if (_sp > XB_SPIN_CAP) { atomicAdd(&(bar)[XB_TMO], 1u); break; } } } } while (0)
struct XcdBarrier { unsigned* bar; unsigned x; volatile LAS unsigned* st; };
__device__ __forceinline__ XcdBarrier xcd_barrier_post(unsigned* bar, volatile LAS unsigned* st) {
    XcdBarrier b; b.bar = bar; b.x = xb_xcc_id(); b.st = st;
    if (threadIdx.x == 0) (void)xb_add(&bar[XB_XCNT(b.x)], 1u);
    return b;
}
__device__ __forceinline__ void xcd_barrier_complete(unsigned* bar, unsigned x, unsigned& nloc, unsigned& nx) {
    const unsigned G = gridDim.x * gridDim.y * gridDim.z;
    unsigned sum, cnt, mine, sp = 0u;
    for (;;) {
        sum = 0u; cnt = 0u; mine = 0u;
#pragma unroll
        for (unsigned j = 0; j < 16; ++j) { const unsigned c = xb_ld(&bar[XB_XCNT(j)]); sum += c; cnt += (c > 0u) ? 1u : 0u; mine = (j == x) ? c : mine; }
        if (sum == G) break;
        __builtin_amdgcn_s_sleep(1);
        if ((++sp & 255u) == 0u) { if (xb_ld(&bar[XB_TMO])) break; if (sp > XB_SPIN_CAP) { atomicAdd(&bar[XB_TMO], 1u); break; } }
    }
    nloc = mine > 0u ? mine : 1u; nx = cnt > 0u ? cnt : 1u;
}
__device__ __forceinline__ void xcd_barrier(const XcdBarrier& b) {
    asm volatile("s_waitcnt vmcnt(0)" ::: "memory");
    __syncthreads();
    if (threadIdx.x == 0) {
        unsigned* bar = b.bar;
        __builtin_amdgcn_s_waitcnt(0);
        unsigned nloc = b.st[0], nx = b.st[1];
        if (nloc == 0u) { xcd_barrier_complete(bar, b.x, nloc, nx); b.st[0] = nloc; b.st[1] = nx; }
        const unsigned old = xb_add(&bar[XB_XSUB(b.x)], 1u);
        const unsigned gen = old / nloc;
        if (old + 1u == (gen + 1u) * nloc) {
            __builtin_amdgcn_fence(__ATOMIC_RELEASE, "agent");
            asm volatile("s_waitcnt vmcnt(0)" ::: "memory");
            const unsigned og = xb_add(&bar[XB_TOP], 1u);
            const unsigned tg = og / nx;
            if (og + 1u == (tg + 1u) * nx) xb_add(&bar[XB_TOPGEN], 1u);
            else XB_SPIN(xb_ld(&bar[XB_TOPGEN]) == tg, bar);
            __builtin_amdgcn_fence(__ATOMIC_ACQUIRE, "agent");
            xb_add(&bar[XB_XGEN(b.x)], 1u);
            asm volatile("s_waitcnt vmcnt(0)" ::: "memory");
        } else {
            XB_SPIN(xb_ld(&bar[XB_XGEN(b.x)]) == gen, bar);
            __builtin_amdgcn_fence(__ATOMIC_ACQUIRE, "agent");
            asm volatile("s_waitcnt vmcnt(0)" ::: "memory");
        }
    }
    __syncthreads();
}

__device__ __forceinline__ unsigned f2bf_u(float f) { unsigned u = __builtin_bit_cast(unsigned, f); return (u + 0x7fffu + ((u >> 16) & 1u)) >> 16; }
__device__ __forceinline__ unsigned pk2(float lo, float hi) { return f2bf_u(lo) | (f2bf_u(hi) << 16); }
__device__ __forceinline__ float wave_sum(float v) {
#pragma unroll
    for (int o = 1; o < 64; o <<= 1) v += __shfl_xor(v, o);
    return v;
}
__device__ __forceinline__ void tr_item(const float* W, int N, bf16* WT, int dp, const float* scale, LAS float* scr, int kb, int nb, int lane) {
    const int k0 = 64 * kb, n0 = 32 * nb;
#pragma unroll 8
    for (int i = 0; i < 32; ++i) { const int kk = 2 * i + (lane >> 5); scr[kk * 33 + (lane & 31)] = W[(size_t)(k0 + kk) * N + n0 + (lane & 31)]; }
    asm volatile("s_waitcnt lgkmcnt(0)" ::: "memory");
    const int c = lane & 7;
#pragma unroll
    for (int j = 0; j < 4; ++j) { const int n = (lane >> 3) + 8 * j; const LAS float* s = scr + (8 * c) * 33 + n; const float sc = scale ? scale[n0 + n] : 1.f;
        u32x4 o; o.x = pk2(s[0 * 33] * sc, s[1 * 33] * sc); o.y = pk2(s[2 * 33] * sc, s[3 * 33] * sc); o.z = pk2(s[4 * 33] * sc, s[5 * 33] * sc); o.w = pk2(s[6 * 33] * sc, s[7 * 33] * sc);
        *(u32x4*)(WT + (size_t)(n0 + n) * dp + k0 + 8 * c) = o; }
    asm volatile("s_waitcnt lgkmcnt(0)" ::: "memory");
}
__device__ __forceinline__ void sincos_d(double ang, float& c, float& s) {
    const double q = rint(ang * 0.63661977236758134308);
    double t = fma(-q, 1.5707963267948966192, ang); t = fma(-q, 6.123233995736766e-17, t);
    const double t2 = t * t;
    double sp = -1.0 / 1307674368000.0; sp = sp * t2 + 1.0 / 6227020800.0; sp = sp * t2 - 1.0 / 39916800.0; sp = sp * t2 + 1.0 / 362880.0; sp = sp * t2 - 1.0 / 5040.0; sp = sp * t2 + 1.0 / 120.0; sp = sp * t2 - 1.0 / 6.0; sp = sp * t2 + 1.0; sp *= t;
    double cp = 1.0 / 20922789888000.0; cp = cp * t2 - 1.0 / 87178291200.0; cp = cp * t2 + 1.0 / 479001600.0; cp = cp * t2 - 1.0 / 3628800.0; cp = cp * t2 + 1.0 / 40320.0; cp = cp * t2 - 1.0 / 720.0; cp = cp * t2 + 1.0 / 24.0; cp = cp * t2 - 0.5; cp = cp * t2 + 1.0;
    const int n = ((int)q) & 3;
    const double ss = (n == 0) ? sp : (n == 1) ? cp : (n == 2) ? -sp : -cp;
    const double cc = (n == 0) ? cp : (n == 1) ? -sp : (n == 2) ? -cp : sp;
    c = (float)cc; s = (float)ss;
}

struct Args { const float* in[9]; float* out; unsigned char* ws; int ph_lo, ph_hi, li, pad; };

__global__ void __launch_bounds__(NWAVES * 64, 2) mk_fwd(Args args) {
    extern __shared__ __attribute__((aligned(16))) unsigned char lds_raw[];
    LAS unsigned char* lds = (LAS unsigned char*)lds_raw;
    volatile LAS unsigned* MISC = (volatile LAS unsigned*)(lds + MISC_OFF);
    const int tid = threadIdx.x, lane = tid & 63, wave = __builtin_amdgcn_readfirstlane(tid >> 6);
    const int G = gridDim.x; const int bx = blockIdx.x; const int vcu = (G % 8 == 0) ? (bx % 8) * (G / 8) + bx / 8 : bx;
    unsigned char* ws = args.ws;
    unsigned* ctl = (unsigned*)(ws + WS_CTL);
    const float* x = args.in[0]; const float* norm_in = args.in[1]; const float* w_in = args.in[2]; const float* w_pool = args.in[3]; const float* pool_scale = args.in[4];
    const float* w_a = args.in[5]; const float* w_b = args.in[6]; const float* w_o = args.in[7]; const float* norm_out = args.in[8];
    float* out = args.out;
    bf16* XB = (bf16*)(ws + WS_XB); bf16* WIN = (bf16*)(ws + WS_WIN); bf16* WAB = (bf16*)(ws + WS_WAB); bf16* WO = (bf16*)(ws + WS_WO); bf16* WPOOLT = (bf16*)(ws + WS_WPOOLT);
    h2_t* TABPF = (h2_t*)(ws + WS_TABPF); h2_t* TABFP = (h2_t*)(ws + WS_TABFP);
    bf16* Q = (bf16*)(ws + WS_Q); bf16* KN = (bf16*)(ws + WS_KN); bf16* PB = KN; bf16* KZT = (bf16*)(ws + WS_KZT); bf16* WSB = (bf16*)(ws + WS_WS); bf16* VT = (bf16*)args.out; bf16* YB = VT;
    float* SSQ = (float*)(ws + WS_SSQ);
    bf16* AIN = (bf16*)(ws + WS_AIN); bf16* YA = (bf16*)(ws + WS_YA); bf16* SA = (bf16*)(ws + WS_SA); bf16* SB = (bf16*)(ws + WS_SB); bf16* POOLED = (bf16*)(ws + WS_POOLED); bf16* MERGED = (bf16*)(ws + WS_MERGED);

    for (int u = tid; u < (LDS_BYTES - LDSCTL_OFF) / 4; u += NWAVES * 64) ((LAS unsigned*)(lds + LDSCTL_OFF))[u] = 0u;
    __syncthreads();
    XcdBarrier bar; bar.bar = ctl + CW_BAR + args.li * XCD_BAR_WORDS; bar.x = 0; bar.st = nullptr;
    if (N_LAUNCHES == 1) bar = xcd_barrier_post(ctl + CW_BAR, MISC + 8);
#define GRID_BAR() do { if (N_LAUNCHES == 1) xcd_barrier(bar); } while (0)
    const int lo = args.ph_lo, hi = args.ph_hi;
#ifndef PH_MASK
#define PH_MASK 0x7ff
#endif
#define IN(k) (((PH_MASK >> (k)) & 1) && lo <= (k) && (k) < hi)
#define BOTH(k) (IN(k) && IN((k) + 1))
    const int gw = vcu * NWAVES + wave, NGW = G * NWAVES;

    if (IN(0)) {
        LAS float* scr = (LAS float*)(lds + wave * 16384);
        constexpr int I_IN = 16 * 320, I_A = 4 * 4 * 32, I_B = 8 * 4 * 32, I_P = 4 * 4 * 8, I_O = 16 * 32, NITEMS = I_IN + I_A + I_B + I_P + I_O;
        for (int it = gw; it < NITEMS; it += NGW) {
            int r = it;
            if (r < I_IN) { tr_item(w_in, DIN, WIN, DM, nullptr, scr, r / 320, r % 320, lane); continue; } r -= I_IN;
            if (r < I_A) { const int s = r / 128, q = r % 128; tr_item(w_a + (size_t)s * 256 * DM, DM, WAB + (size_t)s * 262144, 256, nullptr, scr, q / 32, q % 32, lane); continue; } r -= I_A;
            if (r < I_B) { const int s = r / 128, q = r % 128; tr_item(w_b + (size_t)s * 256 * DM, DM, WAB + (size_t)(4 + s) * 262144, 256, nullptr, scr, q / 32, q % 32, lane); continue; } r -= I_B;
            if (r < I_P) { const int g = r / 32, q = r % 32; tr_item(w_pool + (size_t)g * 65536, 256, WPOOLT + (size_t)g * 65536, 256, pool_scale + g * 256, scr, q / 8, q % 8, lane); continue; } r -= I_P;
            tr_item(w_o, DM, WO, DM, nullptr, scr, r / 32, r % 32, lane);
        }
        for (int row = gw; row < M_TOK; row += NGW) {
            const f32x4* xr = (const f32x4*)(x + (size_t)row * DM) + lane; f32x4 v[4]; float s = 0.f;
#pragma unroll
            for (int j = 0; j < 4; ++j) { v[j] = xr[64 * j]; s += (v[j][0] * v[j][0] + v[j][1] * v[j][1]) + (v[j][2] * v[j][2] + v[j][3] * v[j][3]); }
            const float rstd = 1.0f / sqrtf(wave_sum(s) * (1.f / DM) + NORM_EPS);
            u32x2* o8 = (u32x2*)(XB + (size_t)row * DM) + lane;
#pragma unroll
            for (int j = 0; j < 4; ++j) { const f32x4 gg = ((const f32x4*)norm_in)[lane + 64 * j]; u32x2 o; o.x = pk2(v[j][0] * rstd * gg[0], v[j][1] * rstd * gg[1]); o.y = pk2(v[j][2] * rstd * gg[2], v[j][3] * rstd * gg[3]); o8[64 * j] = o; }
        }
        for (int idx = gw * 64 + lane; idx < SEQ * 128; idx += NGW * 64) {
            const int pos = idx >> 7, f = idx & 127;
            const double inv = exp2(-(double)f * (13.287712379549449 / 128.0));
            float c, s; sincos_d((double)pos * inv, c, s);
            h2_t v; v.x = (_Float16)c; v.y = (_Float16)s;
            TABPF[idx] = v; TABFP[(size_t)f * SEQ + pos] = v;
        }
        if (BOTH(0)) GRID_BAR();
    }
    if (IN(1)) {
        SchedG1 S; S.T.init(64, 20, G, bx); S.XB = (const char*)XB; S.WIN = (const char*)WIN; S.phase = 0;
        EpiG1R E{TABPF, TABFP, Q, KN, KZT, VT};
        pg8::gemm_phase<EpiG1R, SchedG1, true>(lds, DM, S, E);
        if (BOTH(1)) GRID_BAR();
    }
    if (IN(2)) {
        SchedU12 S{G, bx, (const char*)Q, (const char*)KN, (const char*)VT, (const char*)KZT};
        EpiU12 E{PB, WSB};
        pg8::gemm_phase<EpiU12, SchedU12, true>(lds, 256, S, E);
        if (BOTH(2)) GRID_BAR();
    }
    if (IN(3)) {
        for (int idx = (vcu * NWAVES * 64) + tid; idx < 8 * 16384; idx += G * NWAVES * 64) {
            const int bh = idx >> 14, off = (idx & 16383) * 8, h = bh & 3; const float Gd = exp2f(256.f * lg2gamma(h));
            bf16* p = WSB + (size_t)bh * 32 * 131072 + off;
            f32x4 s0 = (f32x4){0.f, 0.f, 0.f, 0.f}, s1 = s0;
#pragma unroll 8
            for (int J = 0; J < 32; ++J) { u32x4* pp = (u32x4*)(p + (size_t)J * 131072); f32x4 w0, w1; unpack8(*pp, w0, w1); *pp = pack8(s0, s1); s0 = s0 * Gd + w0; s1 = s1 * Gd + w1; }
        }
        if (BOTH(3)) GRID_BAR();
    }
    if (IN(4)) {
        SchedU3 S{G, bx, (const char*)Q, (const char*)WSB, (const char*)PB, (const char*)VT};
        EpiU3 E{YB, SSQ};
        pg8::gemm_phase<EpiU3, SchedU3, true>(lds, 256, S, E);
        if (BOTH(4)) GRID_BAR();
    }
    if (IN(5)) {
        SchedG1 S; S.T.init(64, 24, G, bx); S.XB = (const char*)XB; S.WIN = (const char*)WIN; S.phase = 1;
        EpiG1A E{AIN, YA, SA, SB, YB, SSQ};
        pg8::gemm_phase<EpiG1A, SchedG1, true>(lds, DM, S, E);
        if (BOTH(5)) GRID_BAR();
    }
    if (IN(6)) {
        for (int it = gw; it < (M_TOK / 16) * 8; it += NGW) {
            const int tb = it >> 3, cbk = it & 7, g = cbk >> 1, m0 = tb * 16, pos0 = m0 & 8191, c = cbk * 128 + lane * 2;
            float a0[31], a1[31];
#pragma unroll
            for (int k = 0; k < 31; ++k) { const int pos = pos0 - 15 + k; unsigned w = 0u; if (pos >= 0) w = *(const unsigned*)(AIN + (size_t)(m0 - 15 + k) * DM + c); a0[k] = __uint_as_float(w << 16); a1[k] = __uint_as_float(w & 0xffff0000u); }
            float s0[31], s1[31];
#pragma unroll
            for (int k = 0; k < 31; ++k) { s0[k] = a0[k]; s1[k] = a1[k]; }
#pragma unroll
            for (int lv = 0; lv < 4; ++lv) { if (lv <= g) { const int st = 1 << lv;
#pragma unroll
                for (int k = 30; k >= st; --k) { s0[k] += s0[k - st]; s1[k] += s1[k - st]; } } }
            const int w = 2 << g;
#pragma unroll
            for (int k = 0; k < 16; ++k) { const int pos = pos0 + k; const float inv = 1.f / (float)((pos + 1 < w) ? pos + 1 : w);
                *(unsigned*)(POOLED + ((size_t)g * M_TOK + m0 + k) * 256 + (c & 255)) = pk2(s0[15 + k] * inv - a0[15 + k], s1[15 + k] * inv - a1[15 + k]); }
        }
        if (BOTH(6)) GRID_BAR();
    }
    if (IN(7)) {
        SchedPool S; S.T.init(64, 4, G, bx); S.POOLED = (const char*)POOLED; S.WPOOLT = (const char*)WPOOLT;
        EpiPool E{YA};
        pg8::gemm_phase<EpiPool, SchedPool, true>(lds, 256, S, E);
        if (BOTH(7)) GRID_BAR();
    }
    if (IN(8)) {
        SchedG2 S; S.T.init(64, 4, G, bx); S.YA = (const char*)YA; S.YB = (const char*)YB; S.WAB = (const char*)WAB;
        EpiG2 E{SA, SB, MERGED};
        pg8::gemm_phase<EpiG2, SchedG2, true>(lds, 256, S, E);
        if (BOTH(8)) GRID_BAR();
    }
    if (IN(9)) {
        SchedG3 S; S.T.init(64, 4, G, bx); S.MERGED = (const char*)MERGED; S.WO = (const char*)WO;
        EpiG3 E{x, out};
        pg8::gemm_phase<EpiG3, SchedG3, true>(lds, DM, S, E);
        if (BOTH(9)) GRID_BAR();
    }
    if (IN(10)) {
        for (int row = gw; row < M_TOK; row += NGW) {
            f32x4* xr = (f32x4*)(out + (size_t)row * DM) + lane; f32x4 v[4]; float s = 0.f;
#pragma unroll
            for (int j = 0; j < 4; ++j) { v[j] = xr[64 * j]; s += (v[j][0] * v[j][0] + v[j][1] * v[j][1]) + (v[j][2] * v[j][2] + v[j][3] * v[j][3]); }
            const float rstd = 1.0f / sqrtf(wave_sum(s) * (1.f / DM) + NORM_EPS);
#pragma unroll
            for (int j = 0; j < 4; ++j) { const f32x4 gg = ((const f32x4*)norm_out)[lane + 64 * j]; xr[64 * j] = v[j] * rstd * gg; }
        }
    }
#undef IN
#undef BOTH
}

extern "C" void kernel_launch(void* const* d_in, const int* in_sizes, int n_in, void* d_out, int out_size, void* d_ws, size_t ws_size, hipStream_t stream) {
    static int grid = 0;
    if (grid == 0) {
        int dev = 0, cus = 0, per_cu = 0;
        if (hipGetDevice(&dev) != hipSuccess || hipDeviceGetAttribute(&cus, hipDeviceAttributeMultiprocessorCount, dev) != hipSuccess) { fprintf(stderr, "kernel_launch: device query failed\n"); grid = -1; return; }
        if (hipFuncSetAttribute((const void*)mk_fwd, hipFuncAttributeMaxDynamicSharedMemorySize, LDS_BYTES) != hipSuccess) { fprintf(stderr, "kernel_launch: hipFuncSetAttribute failed\n"); grid = -1; return; }
        if (hipOccupancyMaxActiveBlocksPerMultiprocessor(&per_cu, (const void*)mk_fwd, NWAVES * 64, LDS_BYTES) != hipSuccess || per_cu < 1) { fprintf(stderr, "kernel_launch: occupancy query says %d blocks per CU\n", per_cu); }
        (void)hipGetLastError();
        grid = cus;
    }
    if (grid < 0) return;
    (void)hipMemsetAsync((char*)d_ws + WS_CTL, 0, CTL_ZERO_BYTES, stream);
    Args a{};
    for (int i = 0; i < 9; ++i) a.in[i] = (const float*)d_in[i];
    a.out = (float*)d_out; a.ws = (unsigned char*)d_ws;
    for (int li = 0; li < N_LAUNCHES; ++li) {
        a.ph_lo = (N_LAUNCHES == 1) ? 0 : li; a.ph_hi = (N_LAUNCHES == 1) ? N_PHASES : li + 1; a.li = (N_LAUNCHES == 1) ? 0 : 0;
        hipLaunchKernelGGL(mk_fwd, dim3(grid), dim3(NWAVES * 64), LDS_BYTES, stream, a);
    }
}
```

```cpp
#include <hip/hip_runtime.h>
#include <stdint.h>
#include <cstdio>

#ifndef MK_N_LAUNCHES
#define MK_N_LAUNCHES 1
#endif
constexpr int N_PHASES = 11;
constexpr int N_LAUNCHES = MK_N_LAUNCHES;

#define LAS __attribute__((address_space(3)))
#define GAS __attribute__((address_space(1)))
typedef unsigned short bf16;
typedef _Float16 h2_t __attribute__((ext_vector_type(2)));
typedef short bf16x8 __attribute__((ext_vector_type(8)));
typedef float f32x4 __attribute__((ext_vector_type(4)));
typedef unsigned u32x4 __attribute__((ext_vector_type(4)));
typedef unsigned u32x2 __attribute__((ext_vector_type(2)));

constexpr int M_TOK = 16384, SEQ = 8192, DM = 1024, DIN = 10240;
constexpr float NORM_EPS = 1e-6f;
constexpr size_t MiB = 1u << 20;
constexpr size_t WS_CTL = 0, CTL_ZERO_BYTES = 1 * MiB, WS_SSQ = 1 * MiB, WS_WPOOLT = 3 * MiB, WS_WAB = 4 * MiB, WS_WO = 10 * MiB, WS_TABPF = 12 * MiB, WS_TABFP = 16 * MiB,
                 WS_WIN = 20 * MiB, WS_XB = 40 * MiB, WS_Q = 72 * MiB, WS_KN = 104 * MiB, WS_KZT = 136 * MiB, WS_WS = 168 * MiB;
constexpr size_t WS_AIN = 72 * MiB, WS_YA = 104 * MiB, WS_SA = 136 * MiB, WS_SB = 168 * MiB, WS_MERGED = 40 * MiB;
constexpr size_t WS_WINA = 232 * MiB;
constexpr int CW_BAR = 4096;
constexpr int RING_BYTES = 131072, LDSCTL_OFF = RING_BYTES, MISC_OFF = LDSCTL_OFF + 320, LDS_BYTES = 147456;
constexpr int NWAVES = 8;

__device__ __forceinline__ float lg2gamma(int h) { return h == 0 ? -0.04580368961312479f : h == 1 ? -0.02272007650008353f : h == 2 ? -0.011315313227834146f : -0.005646563141142063f; }
__device__ __forceinline__ float siluf(float x) { return x * __builtin_amdgcn_rcpf(1.f + __expf(-x)); }
__device__ __forceinline__ float sigmf(float x) { return __builtin_amdgcn_rcpf(1.f + __expf(-x)); }
typedef float f32x2_t __attribute__((ext_vector_type(2)));
typedef __bf16 bf16x2_t __attribute__((ext_vector_type(2)));
__device__ __forceinline__ unsigned cvt_pk_bf16(float lo, float hi) { const f32x2_t v = {lo, hi}; const bf16x2_t b = __builtin_convertvector(v, bf16x2_t); return __builtin_bit_cast(unsigned, b); }
__device__ __forceinline__ u32x4 pack8(const f32x4 a, const f32x4 b) { u32x4 w; w.x = cvt_pk_bf16(a[0], a[1]); w.y = cvt_pk_bf16(a[2], a[3]); w.z = cvt_pk_bf16(b[0], b[1]); w.w = cvt_pk_bf16(b[2], b[3]); return w; }
__device__ __forceinline__ void unpack8(const u32x4 w, f32x4& a, f32x4& b) {
    a[0] = __uint_as_float(w.x << 16); a[1] = __uint_as_float(w.x & 0xffff0000u); a[2] = __uint_as_float(w.y << 16); a[3] = __uint_as_float(w.y & 0xffff0000u);
    b[0] = __uint_as_float(w.z << 16); b[1] = __uint_as_float(w.z & 0xffff0000u); b[2] = __uint_as_float(w.w << 16); b[3] = __uint_as_float(w.w & 0xffff0000u); }
__device__ __forceinline__ void h2unpack(unsigned w, float& c, float& s) { const h2_t v = __builtin_bit_cast(h2_t, w); c = (float)v.x; s = (float)v.y; }

namespace pg8 {
constexpr int BM = 256, BK = 64, HALF = 128, HTB = HALF * BK * 2, NXCD = 8, WGM = 8;
__host__ __device__ __forceinline__ int lds_byte(int r, int c) { const int st = (r >> 4) * 2 + (c >> 5), rr = r & 15, cc = c & 31, ob = rr * 64 + cc * 2; return st * 1024 + (ob ^ (((ob >> 9) & 1) << 5)); }
__host__ __device__ __forceinline__ void stage_rc(int b, int& R, int& C) { const int st = b / 1024, sb = b % 1024, swz = sb ^ (((sb >> 9) & 1) << 5); R = (st >> 1) * 16 + swz / 64; C = (st & 1) * 32 + (swz % 64) / 2; }
__host__ __device__ __forceinline__ int perm32(int rho) { const int n = rho >> 4, i = rho & 15; return 8 * (i >> 2) + 4 * n + (i & 3); }

struct Seg { const char* A; const char* B; int nt; int kind; int pm; int pn; int seg; };

struct TileOrder {
    int nM, nN, nwg, G, c;
    __device__ void init(int nM_, int nN_, int G_, int c_) { nM = nM_; nN = nN_; nwg = nM * nN; G = G_; c = c_; }
    __device__ bool tile(int i, int& pm, int& pn) const {
        const long L = (long)i * G + c; if (L >= nwg) return false;
        int wgid = (int)L; { const int q = nwg / NXCD, r = nwg % NXCD, xcd = wgid % NXCD, off = wgid / NXCD; wgid = (xcd < r ? xcd * (q + 1) : r * (q + 1) + (xcd - r) * q) + off; }
        const int nig = WGM * nN, gid = wgid / nig, fm = gid * WGM, gsz = (nM - fm) < WGM ? (nM - fm) : WGM;
        pm = fm + ((wgid % nig) % gsz); pn = (wgid % nig) / gsz; return true;
    }
};

template <class Epi, class Sched, bool ALIGN_EPI>
__device__ __forceinline__ void gemm_phase(LAS unsigned char* lds, const int ld, const Sched& S, const Epi& E) {
    const int tid = threadIdx.x, wid = __builtin_amdgcn_readfirstlane(tid >> 6), lane = tid & 63, wr = wid >> 2, wc = wid & 3, fr = lane & 15, fq = lane >> 4;
    unsigned voffA[2], voffB[2];
#pragma unroll
    for (int i = 0; i < 2; ++i) { int R, C; stage_rc(tid * 16 + i * 8192, R, C); const int Rb = Epi::PERM ? ((R & ~31) + perm32(R & 31)) : R;
        voffA[i] = (unsigned)(R * ld + C) * 2u; voffB[i] = (unsigned)(Rb * ld + C) * 2u; }
    const size_t kstep = (size_t)(BK * 2);
    const size_t hstep = (size_t)HALF * ld * 2;
    const unsigned ldsw = (unsigned)wid * 1024u;
    const int aoff = lds_byte(wr * 64 + fr, fq * 8), boff = lds_byte(wc * 32 + fr, fq * 8);
#define PG8_SA(b, h) (((b) * 2 + (h)) * HTB)
#define PG8_SB(b, h) ((4 + (b) * 2 + (h)) * HTB)
#define PG8_STAGE(bufoff, gbase, voff) do { _Pragma("unroll") for (int _i = 0; _i < 2; ++_i) \
        __builtin_amdgcn_global_load_lds((const unsigned*)((const char*)(gbase) + (voff)[_i]), (LAS unsigned*)(lds + (bufoff) + ldsw + _i * 8192), 16, 0, 0); } while (0)
#define PG8_LDA(dst, b, h) do { _Pragma("unroll") for (int m = 0; m < 4; ++m) _Pragma("unroll") for (int k = 0; k < 2; ++k) dst[m][k] = *(const LAS bf16x8*)(lds + PG8_SA(b, h) + aoff + m * 2048 + k * 1024); } while (0)
#define PG8_LDB(dst, b, h) do { _Pragma("unroll") for (int n = 0; n < 2; ++n) _Pragma("unroll") for (int k = 0; k < 2; ++k) dst[n][k] = *(const LAS bf16x8*)(lds + PG8_SB(b, h) + boff + n * 2048 + k * 1024); } while (0)
#define PG8_MMA(ai, bj, At, Bt) do { __builtin_amdgcn_s_setprio(1); _Pragma("unroll") for (int m = 0; m < 4; ++m) _Pragma("unroll") for (int n = 0; n < 2; ++n) _Pragma("unroll") for (int k = 0; k < 2; ++k) \
        acc[ai][bj][m][n] = __builtin_amdgcn_mfma_f32_16x16x32_bf16(Bt[n][k], At[m][k], acc[ai][bj][m][n], 0, 0, 0); __builtin_amdgcn_s_setprio(0); } while (0)
#define PG8_WAIT_V(n) asm volatile("s_waitcnt vmcnt(" #n ")" ::: "memory")
#define PG8_WAIT_L(n) asm volatile("s_waitcnt lgkmcnt(" #n ")" ::: "memory")
#define PG8_BAR __builtin_amdgcn_s_barrier()
#define PG8_SCHED __builtin_amdgcn_sched_barrier(0)
    Seg cur, nxt; int si = 0;
    if (!S.next(0, cur)) return;
    f32x4 acc[2][2][4][2];
#pragma unroll
    for (int a = 0; a < 2; ++a)
#pragma unroll
        for (int b = 0; b < 2; ++b)
#pragma unroll
            for (int m = 0; m < 4; ++m)
#pragma unroll
                for (int n = 0; n < 2; ++n) acc[a][b][m][n] = (f32x4){0.f, 0.f, 0.f, 0.f};
    bf16x8 At[4][2], B0[2][2], B1[2][2];
    const char* cA = cur.A; const char* cB = cur.B;
    PG8_STAGE(PG8_SB(0, 0), cB, voffB); PG8_STAGE(PG8_SB(0, 1), cB + hstep, voffB); PG8_STAGE(PG8_SA(0, 0), cA, voffA); PG8_STAGE(PG8_SA(0, 1), cA + hstep, voffA);
    if (wr == 1) PG8_BAR;
    PG8_WAIT_V(2); PG8_BAR;
    PG8_STAGE(PG8_SB(1, 0), cB + kstep, voffB); PG8_STAGE(PG8_SA(1, 0), cA + kstep, voffA); PG8_STAGE(PG8_SB(1, 1), cB + hstep + kstep, voffB);
    PG8_WAIT_V(6); PG8_BAR;
    for (;;) {
        const bool has_next = S.next(si + 1, nxt);
        const char* nA = has_next ? nxt.A : cA; const char* nB = has_next ? nxt.B : cB;
        const int nt = cur.nt;
        for (int t = 0; t < nt; t += 2) {
            const bool last = (t == nt - 2);
            const char* a1 = cA + (size_t)(t + 1) * kstep;
            const char* a2 = last ? nA : cA + (size_t)(t + 2) * kstep; const char* b2 = last ? nB : cB + (size_t)(t + 2) * kstep;
            const char* a3 = a2 + kstep; const char* b3 = b2 + kstep;
            PG8_LDB(B0, 0, 0); PG8_LDB(B1, 0, 1); PG8_SCHED; PG8_LDA(At, 0, 0); PG8_STAGE(PG8_SA(1, 1), a1 + hstep, voffA);
            PG8_WAIT_V(8); PG8_WAIT_L(0); PG8_BAR; PG8_MMA(0, 0, At, B0); PG8_MMA(0, 1, At, B1); PG8_BAR; PG8_SCHED;
            PG8_LDA(At, 0, 1); PG8_STAGE(PG8_SB(0, 0), b2, voffB); PG8_STAGE(PG8_SB(0, 1), b2 + hstep, voffB); PG8_STAGE(PG8_SA(0, 0), a2, voffA);
            PG8_WAIT_V(8); PG8_WAIT_L(0); PG8_BAR; PG8_MMA(1, 0, At, B0); PG8_MMA(1, 1, At, B1); PG8_BAR; PG8_SCHED;
            PG8_LDB(B0, 1, 0); PG8_LDB(B1, 1, 1); PG8_SCHED; PG8_LDA(At, 1, 0); PG8_STAGE(PG8_SA(0, 1), a2 + hstep, voffA);
            PG8_WAIT_V(8); PG8_WAIT_L(0); PG8_BAR; PG8_MMA(0, 0, At, B0); PG8_MMA(0, 1, At, B1); PG8_BAR; PG8_SCHED;
            PG8_LDA(At, 1, 1); PG8_STAGE(PG8_SB(1, 0), b3, voffB); PG8_STAGE(PG8_SB(1, 1), b3 + hstep, voffB); PG8_STAGE(PG8_SA(1, 0), a3, voffA);
            PG8_WAIT_V(8); PG8_WAIT_L(0); PG8_BAR; PG8_MMA(1, 0, At, B0); PG8_MMA(1, 1, At, B1); PG8_BAR; PG8_SCHED;
        }
        if constexpr (ALIGN_EPI) { if (wr == 0) PG8_BAR; }
        const bool zero = E(acc, cur, wr, wc, fr, fq);
        if (!has_next) break;
        if (zero) {
#pragma unroll
            for (int a = 0; a < 2; ++a)
#pragma unroll
                for (int b = 0; b < 2; ++b)
#pragma unroll
                    for (int m = 0; m < 4; ++m)
#pragma unroll
                        for (int n = 0; n < 2; ++n) acc[a][b][m][n] = (f32x4){0.f, 0.f, 0.f, 0.f};
        }
        cur = nxt; cA = nA; cB = nB; ++si;
        if constexpr (ALIGN_EPI) { if (wr == 1) PG8_BAR; }
    }
    PG8_WAIT_V(0);
    if constexpr (!ALIGN_EPI) { if (wr == 0) PG8_BAR; }
    PG8_BAR;
#undef PG8_SA
#undef PG8_SB
#undef PG8_STAGE
#undef PG8_LDA
#undef PG8_LDB
#undef PG8_MMA
#undef PG8_WAIT_V
#undef PG8_WAIT_L
#undef PG8_BAR
#undef PG8_SCHED
}
}
using pg8::Seg;

#define FOR_AI_M _Pragma("unroll") for (int ai = 0; ai < 2; ++ai) _Pragma("unroll") for (int m = 0; m < 4; ++m)
#define FOR_BJ _Pragma("unroll") for (int bj = 0; bj < 2; ++bj)
typedef f32x4 acc_t[2][2][4][2];
#define EPI_FENCE asm volatile("" ::: "memory")

struct SchedG1 {
    pg8::TileOrder T; const char* XB; const char* WIN; int phase;
    __device__ bool next(int i, Seg& s) const {
        int pm, pn; if (!T.tile(i, pm, pn)) return false;
        int wrow; bool tr = false;
        if (phase == 0) { if (pn < 4) wrow = 2048 + 256 * pn; else if (pn < 8) wrow = 3072 + 256 * (pn - 4); else if (pn < 12) { wrow = 3072 + 256 * (pn - 8); tr = true; } else { wrow = 4096 + 256 * (pn - 12); tr = true; } }
        else { if (pn < 4) wrow = 256 * pn; else if (pn < 8) wrow = 1024 + 256 * (pn - 4); else if (pn < 12) wrow = 8192 + 256 * (pn - 8); else if (pn < 16) wrow = 9216 + 256 * (pn - 12); else wrow = 6144 + 256 * (pn - 16); }
        const char* xp = XB + (size_t)pm * 256 * DM * 2; const char* wp = WIN + (size_t)wrow * DM * 2;
        s.A = tr ? wp : xp; s.B = tr ? xp : wp; s.nt = DM / 64; s.kind = 0; s.pm = pm; s.pn = pn; s.seg = 0; return true;
    }
};
struct EpiG1R {
    static constexpr bool PERM = true;
    const h2_t* TABPF; const h2_t* TABFP; bf16* Q; bf16* KN; bf16* KZT; bf16* VT;
    __device__ __forceinline__ bool operator()(acc_t& acc, const Seg& sg, int wr, int wc, int fr, int fq) const {
        asm volatile("" : "+v"(fr), "+v"(fq));
        const int pm = sg.pm, t = sg.pn, b = pm >> 5, J = pm & 31;
        if (t < 8) {
            const int h = t & 3, bh = b * 4 + h; const float sc = (t < 4) ? 0.0625f : 1.0f;
            bf16* dst = (t < 4 ? Q : KN) + ((size_t)bh * SEQ + J * 256) * 256;
            const int f8 = wc * 32 + fq * 8;
            FOR_AI_M { const int r = ai * 128 + wr * 64 + m * 16 + fr, pos = J * 256 + r;
                const u32x4 t0 = *(const u32x4*)(TABPF + (size_t)pos * 128 + f8), t1 = *(const u32x4*)(TABPF + (size_t)pos * 128 + f8 + 4);
                f32x4 o1[2], o2[2];
#pragma unroll
                for (int n = 0; n < 2; ++n) { const u32x4 tt = n ? t1 : t0; const f32x4 lo = acc[ai][0][m][n], hi = acc[ai][1][m][n];
#pragma unroll
                    for (int j = 0; j < 4; ++j) { float c, s; h2unpack(tt[j], c, s); o1[n][j] = (lo[j] * c - hi[j] * s) * sc; o2[n][j] = (lo[j] * s + hi[j] * c) * sc; } }
                *(u32x4*)(dst + (size_t)r * 256 + f8) = pack8(o1[0], o1[1]); *(u32x4*)(dst + (size_t)r * 256 + f8 + 128) = pack8(o2[0], o2[1]); EPI_FENCE; }
        } else if (t < 12) {
            const int h = (t - 8) & 3, bhJ = (b * 4 + h) * 32 + J; const float lg = lg2gamma(h);
            bf16* dst = KZT + (size_t)bhJ * 65536;
            FOR_BJ { const int c8 = bj * 128 + wc * 32 + fq * 8;
                float z[8];
#pragma unroll
                for (int j = 0; j < 8; ++j) z[j] = __builtin_amdgcn_exp2f((float)(255 - c8 - j) * lg);
#pragma unroll
                for (int m = 0; m < 4; ++m) { const int d = wr * 64 + m * 16 + fr;
                    const h2_t* tp = TABFP + (size_t)d * SEQ + J * 256 + c8; const u32x4 t0 = *(const u32x4*)tp, t1 = *(const u32x4*)(tp + 4);
                    f32x4 o1[2], o2[2];
#pragma unroll
                    for (int n = 0; n < 2; ++n) { const u32x4 tt = n ? t1 : t0; const f32x4 lo = acc[0][bj][m][n], hi = acc[1][bj][m][n];
#pragma unroll
                        for (int j = 0; j < 4; ++j) { float c, s; h2unpack(tt[j], c, s); o1[n][j] = (lo[j] * c - hi[j] * s) * z[n * 4 + j]; o2[n][j] = (lo[j] * s + hi[j] * c) * z[n * 4 + j]; } }
                    *(u32x4*)(dst + (size_t)d * 256 + c8) = pack8(o1[0], o1[1]); *(u32x4*)(dst + (size_t)(d + 128) * 256 + c8) = pack8(o2[0], o2[1]); EPI_FENCE; } }
        } else {
            const int sidx = t - 12; bf16* dst = VT + ((size_t)sidx * M_TOK + b * SEQ + J * 256) * 256;
            FOR_AI_M { const int r = ai * 128 + wr * 64 + m * 16 + fr;
                FOR_BJ { const int c8 = bj * 128 + wc * 32 + fq * 8; *(u32x4*)(dst + (size_t)r * 256 + c8) = pack8(acc[ai][bj][m][0], acc[ai][bj][m][1]); } }
        }
        return true;
    }
};
struct SchedU12 {
    int G, c; const char* Q; const char* KN; const char* VT; const char* KZT;
    __device__ bool next(int i, Seg& s) const {
        const int u = i * G + c; if (u >= 768) return false;
        s.nt = 4; s.seg = 0;
        if (u < 256) { s.kind = 0; s.pm = u; s.pn = 0; s.A = Q + (size_t)u * 131072; s.B = KN + (size_t)u * 131072; }
        else { const int v = u - 256, bhJ = v >> 1, eh = v & 1, b = bhJ >> 7, h = (bhJ >> 5) & 3, J = bhJ & 31, sidx = h * 2 + eh;
            s.kind = 1; s.pm = bhJ; s.pn = eh; s.A = VT + ((size_t)sidx * M_TOK + b * SEQ + J * 256) * 512; s.B = KZT + (size_t)bhJ * 131072; }
        return true;
    }
};
struct EpiU12 {
    static constexpr bool PERM = true;
    bf16* PB; bf16* WS;
    __device__ __forceinline__ bool operator()(acc_t& acc, const Seg& sg, int wr, int wc, int fr, int fq) const {
        asm volatile("" : "+v"(fr), "+v"(fq));
        if (sg.kind == 0) {
            const int bhJ = sg.pm, h = (bhJ >> 5) & 3; const float lg = lg2gamma(h); bf16* dst = PB + (size_t)bhJ * 65536;
            FOR_AI_M { const int i = ai * 128 + wr * 64 + m * 16 + fr;
                FOR_BJ { const int c8 = bj * 128 + wc * 32 + fq * 8; f32x4 o[2];
#pragma unroll
                    for (int n = 0; n < 2; ++n)
#pragma unroll
                        for (int j = 0; j < 4; ++j) { const int jj = c8 + n * 4 + j, dd = i > jj ? i - jj : jj - i; const float w = ((jj >> 6) <= (i >> 6)) ? __builtin_amdgcn_exp2f((float)dd * lg) : 0.f; o[n][j] = acc[ai][bj][m][n][j] * w; }
                    *(u32x4*)(dst + (size_t)i * 256 + c8) = pack8(o[0], o[1]); EPI_FENCE; } }
        } else {
            bf16* dst = WS + (size_t)sg.pm * 131072 + (size_t)sg.pn * 65536;
            FOR_AI_M { const int r = ai * 128 + wr * 64 + m * 16 + fr;
                FOR_BJ { const int c8 = bj * 128 + wc * 32 + fq * 8; *(u32x4*)(dst + (size_t)r * 256 + c8) = pack8(acc[ai][bj][m][0], acc[ai][bj][m][1]); } }
        }
        return true;
    }
};
struct SchedU3 {
    int G, c; const char* Q; const char* WS; const char* PB; const char* VT;
    __device__ bool next(int si, Seg& s) const {
        const int u = (si >> 1) * G + c, sg = si & 1; if (u >= 512) return false;
        const int bhJ = u >> 1, eh = u & 1, b = bhJ >> 7, h = (bhJ >> 5) & 3, J = bhJ & 31, sidx = h * 2 + eh;
        s.nt = 4; s.seg = sg; s.kind = 0; s.pm = bhJ; s.pn = eh;
        if (sg == 0) { s.A = Q + (size_t)bhJ * 131072; s.B = WS + (size_t)bhJ * 262144 + (size_t)eh * 131072; }
        else { s.A = PB + (size_t)bhJ * 131072; s.B = VT + ((size_t)sidx * M_TOK + b * SEQ + J * 256) * 512; }
        return true;
    }
};
struct EpiU3 {
    static constexpr bool PERM = true;
    bf16* YB; float* SSQ;
    __device__ __forceinline__ bool operator()(acc_t& acc, const Seg& sg, int wr, int wc, int fr, int fq) const {
        asm volatile("" : "+v"(fr), "+v"(fq));
        const int bhJ = sg.pm, eh = sg.pn, b = bhJ >> 7, h = (bhJ >> 5) & 3, J = bhJ & 31, sidx = h * 2 + eh;
        if (sg.seg == 0) {
            const float lg = lg2gamma(h);
            FOR_AI_M { const int i = ai * 128 + wr * 64 + m * 16 + fr; const float w = __builtin_amdgcn_exp2f((float)(i + 1) * lg);
                FOR_BJ { acc[ai][bj][m][0] *= w; acc[ai][bj][m][1] *= w; } }
            return false;
        }
        bf16* dst = YB + ((size_t)sidx * M_TOK + b * SEQ + J * 256) * 256;
        FOR_AI_M { const int i = ai * 128 + wr * 64 + m * 16 + fr; float ss = 0.f;
            FOR_BJ { const int c8 = bj * 128 + wc * 32 + fq * 8; const f32x4 v0 = acc[ai][bj][m][0], v1 = acc[ai][bj][m][1];
                ss += (v0[0] * v0[0] + v0[1] * v0[1]) + (v0[2] * v0[2] + v0[3] * v0[3]) + (v1[0] * v1[0] + v1[1] * v1[1]) + (v1[2] * v1[2] + v1[3] * v1[3]);
                *(u32x4*)(dst + (size_t)i * 256 + c8) = pack8(v0, v1); }
            ss += __shfl_xor(ss, 16); ss += __shfl_xor(ss, 32);
            if (fq == 0) SSQ[(size_t)(b * SEQ + J * 256 + i) * 32 + h * 8 + eh * 4 + wc] = ss; EPI_FENCE; }
        return true;
    }
};
struct EpiG1A {
    static constexpr bool PERM = true;
    bf16* AIN; bf16* YA; bf16* SA; bf16* SB; bf16* YB; const float* SSQ;
    __device__ __forceinline__ bool operator()(acc_t& acc, const Seg& sg, int wr, int wc, int fr, int fq) const {
        asm volatile("" : "+v"(fr), "+v"(fq));
        const int t = sg.pn; const size_t m0 = (size_t)sg.pm * 256;
        FOR_AI_M { const size_t mm = m0 + ai * 128 + wr * 64 + m * 16 + fr; float rn = 1.f;
            if (t >= 16) { const float* sp = SSQ + mm * 32 + ((t - 16) >> 1) * 8; const f32x4 a = *(const f32x4*)sp, b = *(const f32x4*)(sp + 4); rn = 1.0f / sqrtf((((a[0] + a[1]) + (a[2] + a[3])) + ((b[0] + b[1]) + (b[2] + b[3]))) * (1.f / 512.f) + NORM_EPS); }
            FOR_BJ { const int c8 = bj * 128 + wc * 32 + fq * 8; f32x4 v0 = acc[ai][bj][m][0], v1 = acc[ai][bj][m][1];
                if (t < 4) { *(u32x4*)(AIN + mm * DM + t * 256 + c8) = pack8(v0, v1); }
                else if (t < 8) {
#pragma unroll
                    for (int j = 0; j < 4; ++j) { v0[j] = siluf(v0[j]); v1[j] = siluf(v1[j]); }
                    *(u32x4*)(YA + ((size_t)(t - 4) * M_TOK + mm) * 256 + c8) = pack8(v0, v1); }
                else if (t < 16) {
#pragma unroll
                    for (int j = 0; j < 4; ++j) { v0[j] = sigmf(v0[j]); v1[j] = sigmf(v1[j]); }
                    *(u32x4*)((t < 12 ? SA : SB) + mm * DM + ((t - 8) & 3) * 256 + c8) = pack8(v0, v1); }
                else { bf16* p = YB + ((size_t)(t - 16) * M_TOK + mm) * 256 + c8; f32x4 y0, y1; unpack8(*(const u32x4*)p, y0, y1);
#pragma unroll
                    for (int j = 0; j < 4; ++j) { v0[j] = y0[j] * rn * siluf(v0[j]); v1[j] = y1[j] * rn * siluf(v1[j]); }
                    *(u32x4*)p = pack8(v0, v1); } } EPI_FENCE; }
        return true;
    }
};
struct SchedWP {
    int u; const char* WPOOLT; const char* WINA;
    __device__ bool next(int i, Seg& s) const { if (i > 0 || u >= 16) return false; const int g = u >> 2, kp = u & 3;
        s.A = WPOOLT + (size_t)g * 131072; s.B = WINA + ((size_t)g * DM + kp * 256) * 512; s.nt = 4; s.kind = 0; s.pm = g; s.pn = kp; s.seg = 0; return true; }
};
struct EpiWP {
    static constexpr bool PERM = true;
    bf16* WIN;
    __device__ __forceinline__ bool operator()(acc_t& acc, const Seg& sg, int wr, int wc, int fr, int fq) const {
        asm volatile("" : "+v"(fr), "+v"(fq));
        bf16* dst = WIN + (size_t)sg.pm * 256 * DM + sg.pn * 256;
        FOR_AI_M { const int r = ai * 128 + wr * 64 + m * 16 + fr;
            FOR_BJ { const int c8 = bj * 128 + wc * 32 + fq * 8; *(u32x4*)(dst + (size_t)r * DM + c8) = pack8(acc[ai][bj][m][0], acc[ai][bj][m][1]); } }
        return true;
    }
};
struct SchedG2 {
    pg8::TileOrder T; const char* YA; const char* YB; const char* WAB;
    __device__ bool next(int si, Seg& s) const { const int ui = si / 12, sg = si - ui * 12; int pm, pn; if (!T.tile(ui, pm, pn)) return false;
        s.A = (sg < 4 ? YA + ((size_t)sg * M_TOK + (size_t)pm * 256) * 512 : YB + ((size_t)(sg - 4) * M_TOK + (size_t)pm * 256) * 512);
        s.B = WAB + (size_t)sg * 524288 + (size_t)pn * 131072; s.nt = 4; s.kind = 0; s.pm = pm; s.pn = pn; s.seg = sg; return true; }
};
struct EpiG2 {
    static constexpr bool PERM = true;
    const bf16* SA; const bf16* SB; bf16* MERGED;
    __device__ __forceinline__ bool operator()(acc_t& acc, const Seg& sg, int wr, int wc, int fr, int fq) const {
        asm volatile("" : "+v"(fr), "+v"(fq));
        const int s = sg.seg; const size_t m0 = (size_t)sg.pm * 256; const int cb = sg.pn * 256;
        if (s == 3 || s == 11) {
            const bool fin = (s == 11); const bf16* GT = fin ? SB : SA;
            FOR_AI_M { const int r = ai * 128 + wr * 64 + m * 16 + fr; const size_t mm = m0 + r;
                FOR_BJ { const int c8 = cb + bj * 128 + wc * 32 + fq * 8; f32x4 g0, g1, t0, t1; unpack8(*(const u32x4*)(GT + mm * DM + c8), g0, g1); unpack8(*(const u32x4*)(MERGED + mm * DM + c8), t0, t1);
#pragma unroll
                    for (int j = 0; j < 4; ++j) { t0[j] = fin ? t0[j] : 0.f; t1[j] = fin ? t1[j] : 0.f; }
                    *(u32x4*)(MERGED + mm * DM + c8) = pack8(acc[ai][bj][m][0] * g0 + t0, acc[ai][bj][m][1] * g1 + t1); EPI_FENCE; } }
            return true;
        }
        return false;
    }
};
struct SchedG3 {
    pg8::TileOrder T; const char* MERGED; const char* WO;
    __device__ bool next(int i, Seg& s) const { int pm, pn; if (!T.tile(i, pm, pn)) return false;
        s.A = MERGED + (size_t)pm * 256 * DM * 2; s.B = WO + (size_t)pn * 256 * DM * 2; s.nt = DM / 64; s.kind = 0; s.pm = pm; s.pn = pn; s.seg = 0; return true; }
};
struct EpiG3 {
    static constexpr bool PERM = false;
    const float* X; float* OUT;
    __device__ __forceinline__ bool operator()(acc_t& acc, const Seg& sg, int wr, int wc, int fr, int fq) const {
        asm volatile("" : "+v"(fr), "+v"(fq));
        FOR_AI_M { const size_t mm = (size_t)sg.pm * 256 + ai * 128 + wr * 64 + m * 16 + fr;
            FOR_BJ {
#pragma unroll
                for (int n = 0; n < 2; ++n) { const size_t o = mm * DM + sg.pn * 256 + bj * 128 + wc * 32 + n * 16 + fq * 4; *(f32x4*)(OUT + o) = *(const f32x4*)(X + o) + acc[ai][bj][m][n]; } } }
        return true;
    }
};

#define XB_TMO      128
#define XB_XCNT(j)  (256  + 64 * (j))
#define XB_XSUB(j)  (1280 + 64 * (j))
#define XB_XGEN(j)  (2304 + 64 * (j))
#define XB_TOP      3328
#define XB_TOPGEN   3392
#define XCD_BAR_WORDS 3456
#define XB_SPIN_CAP (1u << 18)
__device__ __forceinline__ unsigned xb_ld(unsigned* p)              { return __hip_atomic_load(p, __ATOMIC_RELAXED, __HIP_MEMORY_SCOPE_AGENT); }
__device__ __forceinline__ unsigned xb_add(unsigned* p, unsigned v) { return __hip_atomic_fetch_add(p, v, __ATOMIC_RELAXED, __HIP_MEMORY_SCOPE_AGENT); }
__device__ __forceinline__ unsigned xb_xcc_id() { return (unsigned)__builtin_amdgcn_s_getreg((3 << 11) | 20) & 0xFu; }
#define XB_SPIN(cond, bar) do { unsigned _sp = 0; while (cond) { __builtin_amdgcn_s_sleep(1); \
    if ((++_sp & 255u) == 0u) { if (xb_ld(&(bar)[XB_TMO])) break; if (_sp > XB_SPIN_CAP) { atomicAdd(&(bar)[XB_TMO], 1u); break; } } } } while (0)
struct XcdBarrier { unsigned* bar; unsigned x; volatile LAS unsigned* st; };
__device__ __forceinline__ XcdBarrier xcd_barrier_post(unsigned* bar, volatile LAS unsigned* st) {
    XcdBarrier b; b.bar = bar; b.x = xb_xcc_id(); b.st = st;
    if (threadIdx.x == 0) (void)xb_add(&bar[XB_XCNT(b.x)], 1u);
    return b;
}
__device__ __forceinline__ void xcd_barrier_complete(unsigned* bar, unsigned x, unsigned& nloc, unsigned& nx) {
    const unsigned G = gridDim.x * gridDim.y * gridDim.z;
    unsigned sum, cnt, mine, sp = 0u;
    for (;;) {
        sum = 0u; cnt = 0u; mine = 0u;
#pragma unroll
        for (unsigned j = 0; j < 16; ++j) { const unsigned c = xb_ld(&bar[XB_XCNT(j)]); sum += c; cnt += (c > 0u) ? 1u : 0u; mine = (j == x) ? c : mine; }
        if (sum == G) break;
        __builtin_amdgcn_s_sleep(1);
        if ((++sp & 255u) == 0u) { if (xb_ld(&bar[XB_TMO])) break; if (sp > XB_SPIN_CAP) { atomicAdd(&bar[XB_TMO], 1u); break; } }
    }
    nloc = mine > 0u ? mine : 1u; nx = cnt > 0u ? cnt : 1u;
}
__device__ __forceinline__ void xcd_barrier(const XcdBarrier& b) {
    asm volatile("s_waitcnt vmcnt(0)" ::: "memory");
    __syncthreads();
    if (threadIdx.x == 0) {
        unsigned* bar = b.bar;
        __builtin_amdgcn_s_waitcnt(0);
        unsigned nloc = b.st[0], nx = b.st[1];
        if (nloc == 0u) { xcd_barrier_complete(bar, b.x, nloc, nx); b.st[0] = nloc; b.st[1] = nx; }
        const unsigned old = xb_add(&bar[XB_XSUB(b.x)], 1u);
        const unsigned gen = old / nloc;
        if (old + 1u == (gen + 1u) * nloc) {
            __builtin_amdgcn_fence(__ATOMIC_RELEASE, "agent");
            asm volatile("s_waitcnt vmcnt(0)" ::: "memory");
            const unsigned og = xb_add(&bar[XB_TOP], 1u);
            const unsigned tg = og / nx;
            if (og + 1u == (tg + 1u) * nx) xb_add(&bar[XB_TOPGEN], 1u);
            else XB_SPIN(xb_ld(&bar[XB_TOPGEN]) == tg, bar);
            __builtin_amdgcn_fence(__ATOMIC_ACQUIRE, "agent");
            xb_add(&bar[XB_XGEN(b.x)], 1u);
            asm volatile("s_waitcnt vmcnt(0)" ::: "memory");
        } else {
            XB_SPIN(xb_ld(&bar[XB_XGEN(b.x)]) == gen, bar);
            __builtin_amdgcn_fence(__ATOMIC_ACQUIRE, "agent");
            asm volatile("s_waitcnt vmcnt(0)" ::: "memory");
        }
    }
    __syncthreads();
}

__device__ __forceinline__ unsigned f2bf_u(float f) { unsigned u = __builtin_bit_cast(unsigned, f); return (u + 0x7fffu + ((u >> 16) & 1u)) >> 16; }
__device__ __forceinline__ unsigned pk2(float lo, float hi) { return f2bf_u(lo) | (f2bf_u(hi) << 16); }
__device__ __forceinline__ float wave_sum(float v) {
#pragma unroll
    for (int o = 1; o < 64; o <<= 1) v += __shfl_xor(v, o);
    return v;
}
__device__ __forceinline__ void tr_item(const float* W, int N, bf16* WT, int dp, const float* scale, LAS float* scr, int kb, int nb, int lane) {
    const int k0 = 64 * kb, n0 = 32 * nb;
#pragma unroll 8
    for (int i = 0; i < 32; ++i) { const int kk = 2 * i + (lane >> 5); scr[kk * 33 + (lane & 31)] = W[(size_t)(k0 + kk) * N + n0 + (lane & 31)]; }
    asm volatile("s_waitcnt lgkmcnt(0)" ::: "memory");
    const int c = lane & 7;
#pragma unroll
    for (int j = 0; j < 4; ++j) { const int n = (lane >> 3) + 8 * j; const LAS float* s = scr + (8 * c) * 33 + n; const float sc = scale ? scale[n0 + n] : 1.f;
        u32x4 o; o.x = pk2(s[0 * 33] * sc, s[1 * 33] * sc); o.y = pk2(s[2 * 33] * sc, s[3 * 33] * sc); o.z = pk2(s[4 * 33] * sc, s[5 * 33] * sc); o.w = pk2(s[6 * 33] * sc, s[7 * 33] * sc);
        *(u32x4*)(WT + (size_t)(n0 + n) * dp + k0 + 8 * c) = o; }
    asm volatile("s_waitcnt lgkmcnt(0)" ::: "memory");
}
__device__ __forceinline__ void sincos_d(double ang, float& c, float& s) {
    const double q = rint(ang * 0.63661977236758134308);
    double t = fma(-q, 1.5707963267948966192, ang); t = fma(-q, 6.123233995736766e-17, t);
    const double t2 = t * t;
    double sp = -1.0 / 1307674368000.0; sp = sp * t2 + 1.0 / 6227020800.0; sp = sp * t2 - 1.0 / 39916800.0; sp = sp * t2 + 1.0 / 362880.0; sp = sp * t2 - 1.0 / 5040.0; sp = sp * t2 + 1.0 / 120.0; sp = sp * t2 - 1.0 / 6.0; sp = sp * t2 + 1.0; sp *= t;
    double cp = 1.0 / 20922789888000.0; cp = cp * t2 - 1.0 / 87178291200.0; cp = cp * t2 + 1.0 / 479001600.0; cp = cp * t2 - 1.0 / 3628800.0; cp = cp * t2 + 1.0 / 40320.0; cp = cp * t2 - 1.0 / 720.0; cp = cp * t2 + 1.0 / 24.0; cp = cp * t2 - 0.5; cp = cp * t2 + 1.0;
    const int n = ((int)q) & 3;
    const double ss = (n == 0) ? sp : (n == 1) ? cp : (n == 2) ? -sp : -cp;
    const double cc = (n == 0) ? cp : (n == 1) ? -sp : (n == 2) ? -cp : sp;
    c = (float)cc; s = (float)ss;
}

struct Args { const float* in[9]; float* out; unsigned char* ws; int ph_lo, ph_hi, li, pad; };

__global__ void __launch_bounds__(NWAVES * 64, 2) mk_fwd(Args args) {
    extern __shared__ __attribute__((aligned(16))) unsigned char lds_raw[];
    LAS unsigned char* lds = (LAS unsigned char*)lds_raw;
    volatile LAS unsigned* MISC = (volatile LAS unsigned*)(lds + MISC_OFF);
    const int tid = threadIdx.x, lane = tid & 63, wave = __builtin_amdgcn_readfirstlane(tid >> 6);
    const int G = gridDim.x; const int bx = blockIdx.x; const int vcu = (G % 8 == 0) ? (bx % 8) * (G / 8) + bx / 8 : bx;
    unsigned char* ws = args.ws;
    unsigned* ctl = (unsigned*)(ws + WS_CTL);
    const float* x = args.in[0]; const float* norm_in = args.in[1]; const float* w_in = args.in[2]; const float* w_pool = args.in[3]; const float* pool_scale = args.in[4];
    const float* w_a = args.in[5]; const float* w_b = args.in[6]; const float* w_o = args.in[7]; const float* norm_out = args.in[8];
    float* out = args.out;
    bf16* XB = (bf16*)(ws + WS_XB); bf16* WIN = (bf16*)(ws + WS_WIN); bf16* WAB = (bf16*)(ws + WS_WAB); bf16* WO = (bf16*)(ws + WS_WO); bf16* WPOOLT = (bf16*)(ws + WS_WPOOLT);
    h2_t* TABPF = (h2_t*)(ws + WS_TABPF); h2_t* TABFP = (h2_t*)(ws + WS_TABFP);
    bf16* Q = (bf16*)(ws + WS_Q); bf16* KN = (bf16*)(ws + WS_KN); bf16* PB = KN; bf16* KZT = (bf16*)(ws + WS_KZT); bf16* WSB = (bf16*)(ws + WS_WS); bf16* VT = (bf16*)args.out; bf16* YB = VT;
    float* SSQ = (float*)(ws + WS_SSQ);
    bf16* AIN = (bf16*)(ws + WS_AIN); bf16* YA = (bf16*)(ws + WS_YA); bf16* SA = (bf16*)(ws + WS_SA); bf16* SB = (bf16*)(ws + WS_SB); bf16* MERGED = (bf16*)(ws + WS_MERGED); bf16* WINA = (bf16*)(ws + WS_WINA);

    for (int u = tid; u < (LDS_BYTES - LDSCTL_OFF) / 4; u += NWAVES * 64) ((LAS unsigned*)(lds + LDSCTL_OFF))[u] = 0u;
    __syncthreads();
    XcdBarrier bar; bar.bar = ctl + CW_BAR + args.li * XCD_BAR_WORDS; bar.x = 0; bar.st = nullptr;
    if (N_LAUNCHES == 1) bar = xcd_barrier_post(ctl + CW_BAR, MISC + 8);
#define GRID_BAR() do { if (N_LAUNCHES == 1) xcd_barrier(bar); } while (0)
#ifdef DBG_TIME_A
    int dbg_ph = 0; if (tid == 0) MISC[15] = (unsigned)__builtin_amdgcn_s_memrealtime();
#define STAMP() do { if (tid == 0) MISC[16 + dbg_ph] = (unsigned)__builtin_amdgcn_s_memrealtime(); ++dbg_ph; } while (0)
#else
#define STAMP() do {} while (0)
#endif
    const int lo = args.ph_lo, hi = args.ph_hi;
#ifndef PH_MASK
#define PH_MASK 0x7ff
#endif
#define IN(k) (((PH_MASK >> (k)) & 1) && lo <= (k) && (k) < hi)
#define BOTH(k) (IN(k) && IN((k) + 1))
    const int gw = vcu * NWAVES + wave, NGW = G * NWAVES;

    if (IN(0)) {
        LAS float* scr = (LAS float*)(lds + wave * 16384);
        constexpr int I_IN = 16 * 320, I_A = 4 * 4 * 32, I_B = 8 * 4 * 32, I_P = 4 * 4 * 8, I_O = 16 * 32, NITEMS = I_IN + I_A + I_B + I_P + I_O;
        for (int it = gw; it < NITEMS; it += NGW) {
            int r = it;
            if (r < I_IN) { const int nb = r % 320; if (nb >= 32) tr_item(w_in, DIN, WIN, DM, nullptr, scr, r / 320, nb, lane); continue; } r -= I_IN;
            if (r < I_A) { const int s = r / 128, q = r % 128; tr_item(w_a + (size_t)s * 256 * DM, DM, WAB + (size_t)s * 262144, 256, nullptr, scr, q / 32, q % 32, lane); continue; } r -= I_A;
            if (r < I_B) { const int s = r / 128, q = r % 128; tr_item(w_b + (size_t)s * 256 * DM, DM, WAB + (size_t)(4 + s) * 262144, 256, nullptr, scr, q / 32, q % 32, lane); continue; } r -= I_B;
            if (r < I_P) { const int g = r / 32, q = r % 32; tr_item(w_pool + (size_t)g * 65536, 256, WPOOLT + (size_t)g * 65536, 256, pool_scale + g * 256, scr, q / 8, q % 8, lane); continue; } r -= I_P;
            tr_item(w_o, DM, WO, DM, nullptr, scr, r / 32, r % 32, lane);
        }
        for (int row = gw; row < M_TOK; row += NGW) {
            const f32x4* xr = (const f32x4*)(x + (size_t)row * DM) + lane; f32x4 v[4]; float s = 0.f;
#pragma unroll
            for (int j = 0; j < 4; ++j) { v[j] = xr[64 * j]; s += (v[j][0] * v[j][0] + v[j][1] * v[j][1]) + (v[j][2] * v[j][2] + v[j][3] * v[j][3]); }
            const float rstd = 1.0f / sqrtf(wave_sum(s) * (1.f / DM) + NORM_EPS);
            u32x2* o8 = (u32x2*)(XB + (size_t)row * DM) + lane;
#pragma unroll
            for (int j = 0; j < 4; ++j) { const f32x4 gg = ((const f32x4*)norm_in)[lane + 64 * j]; u32x2 o; o.x = pk2(v[j][0] * rstd * gg[0], v[j][1] * rstd * gg[1]); o.y = pk2(v[j][2] * rstd * gg[2], v[j][3] * rstd * gg[3]); o8[64 * j] = o; }
        }
        for (int idx = gw * 64 + lane; idx < DM * 128; idx += NGW * 64) {
            const int k = idx >> 7, c8 = (idx & 127) * 8, g = c8 >> 8; const f32x4 a = *(const f32x4*)(w_in + (size_t)k * DIN + c8), b = *(const f32x4*)(w_in + (size_t)k * DIN + c8 + 4);
            u32x4 o; o.x = pk2(a[0], a[1]); o.y = pk2(a[2], a[3]); o.z = pk2(b[0], b[1]); o.w = pk2(b[2], b[3]); *(u32x4*)(WINA + ((size_t)g * DM + k) * 256 + (c8 & 255)) = o; }
        for (int idx = gw * 64 + lane; idx < SEQ * 128; idx += NGW * 64) {
            const int pos = idx >> 7, f = idx & 127;
            const double inv = exp2(-(double)f * (13.287712379549449 / 128.0));
            float c, s; sincos_d((double)pos * inv, c, s);
            h2_t v; v.x = (_Float16)c; v.y = (_Float16)s;
            TABPF[idx] = v; TABFP[(size_t)f * SEQ + pos] = v;
        }
        if (BOTH(0)) GRID_BAR(); STAMP();
    }
    if (IN(1)) {
        SchedG1 S; S.T.init(64, 20, G, bx); S.XB = (const char*)XB; S.WIN = (const char*)WIN; S.phase = 0;
        EpiG1R E{TABPF, TABFP, Q, KN, KZT, VT};
        pg8::gemm_phase<EpiG1R, SchedG1, true>(lds, DM, S, E);
        if (BOTH(1)) GRID_BAR(); STAMP();
    }
    if (IN(2)) {
        SchedU12 S{G, bx, (const char*)Q, (const char*)KN, (const char*)VT, (const char*)KZT};
        EpiU12 E{PB, WSB};
        pg8::gemm_phase<EpiU12, SchedU12, true>(lds, 256, S, E);
        if (BOTH(2)) GRID_BAR(); STAMP();
    }
    if (IN(3)) {
        if (bx < 16) { SchedWP S{bx, (const char*)WPOOLT, (const char*)WINA}; EpiWP E{WIN}; pg8::gemm_phase<EpiWP, SchedWP, false>(lds, 256, S, E); }
        for (int idx = (vcu * NWAVES * 64) + tid; idx < 8 * 16384; idx += G * NWAVES * 64) {
            const int bh = idx >> 14, off = (idx & 16383) * 8, h = bh & 3; const float Gd = exp2f(256.f * lg2gamma(h));
            bf16* p = WSB + (size_t)bh * 32 * 131072 + off;
            f32x4 s0 = (f32x4){0.f, 0.f, 0.f, 0.f}, s1 = s0;
#pragma unroll 8
            for (int J = 0; J < 32; ++J) { u32x4* pp = (u32x4*)(p + (size_t)J * 131072); f32x4 w0, w1; unpack8(*pp, w0, w1); *pp = pack8(s0, s1); s0 = s0 * Gd + w0; s1 = s1 * Gd + w1; }
        }
        if (BOTH(3)) GRID_BAR(); STAMP();
    }
    if (IN(4)) {
        SchedU3 S{G, bx, (const char*)Q, (const char*)WSB, (const char*)PB, (const char*)VT};
        EpiU3 E{YB, SSQ};
        pg8::gemm_phase<EpiU3, SchedU3, true>(lds, 256, S, E);
        if (BOTH(4)) GRID_BAR(); STAMP();
    }
    if (IN(5)) {
        SchedG1 S; S.T.init(64, 24, G, bx); S.XB = (const char*)XB; S.WIN = (const char*)WIN; S.phase = 1;
        EpiG1A E{AIN, YA, SA, SB, YB, SSQ};
        pg8::gemm_phase<EpiG1A, SchedG1, true>(lds, DM, S, E);
        if (BOTH(5)) GRID_BAR(); STAMP();
    }
    if (IN(6)) {
        for (int it = gw; it < (M_TOK / 16) * 8; it += NGW) {
            const int tb = it >> 3, cbk = it & 7, g = cbk >> 1, m0 = tb * 16, pos0 = m0 & 8191, c = cbk * 128 + lane * 2;
            float a0[31], a1[31];
#pragma unroll
            for (int k = 0; k < 31; ++k) { const int pos = pos0 - 15 + k; unsigned w = 0u; if (pos >= 0) w = *(const unsigned*)(AIN + (size_t)(m0 - 15 + k) * DM + c); a0[k] = __uint_as_float(w << 16); a1[k] = __uint_as_float(w & 0xffff0000u); }
            unsigned gt[16];
#pragma unroll
            for (int k = 0; k < 16; ++k) gt[k] = *(const unsigned*)(YA + ((size_t)g * M_TOK + m0 + k) * 256 + (c & 255));
            float s0[31], s1[31];
#pragma unroll
            for (int k = 0; k < 31; ++k) { s0[k] = a0[k]; s1[k] = a1[k]; }
#pragma unroll
            for (int lv = 0; lv < 4; ++lv) { if (lv <= g) { const int st = 1 << lv;
#pragma unroll
                for (int k = 30; k >= st; --k) { s0[k] += s0[k - st]; s1[k] += s1[k - st]; } } }
            const int w = 2 << g;
#pragma unroll
            for (int k = 0; k < 16; ++k) { const int pos = pos0 + k; const float inv = 1.f / (float)((pos + 1 < w) ? pos + 1 : w);
                const float g0 = __uint_as_float(gt[k] << 16), g1 = __uint_as_float(gt[k] & 0xffff0000u);
                *(unsigned*)(YA + ((size_t)g * M_TOK + m0 + k) * 256 + (c & 255)) = pk2((s0[15 + k] * inv - a0[15 + k]) * g0, (s1[15 + k] * inv - a1[15 + k]) * g1); }
        }
        if (BOTH(6)) GRID_BAR(); STAMP();
    }
    if (IN(7)) { STAMP(); }
    if (IN(8)) {
        SchedG2 S; S.T.init(64, 4, G, bx); S.YA = (const char*)YA; S.YB = (const char*)YB; S.WAB = (const char*)WAB;
        EpiG2 E{SA, SB, MERGED};
        pg8::gemm_phase<EpiG2, SchedG2, true>(lds, 256, S, E);
        if (BOTH(8)) GRID_BAR(); STAMP();
    }
    if (IN(9)) {
        SchedG3 S; S.T.init(64, 4, G, bx); S.MERGED = (const char*)MERGED; S.WO = (const char*)WO;
        EpiG3 E{x, out};
        pg8::gemm_phase<EpiG3, SchedG3, true>(lds, DM, S, E);
        if (BOTH(9)) GRID_BAR(); STAMP();
    }
    if (IN(10)) {
        for (int row = gw; row < M_TOK; row += NGW) {
            f32x4* xr = (f32x4*)(out + (size_t)row * DM) + lane; f32x4 v[4]; float s = 0.f;
#pragma unroll
            for (int j = 0; j < 4; ++j) { v[j] = xr[64 * j]; s += (v[j][0] * v[j][0] + v[j][1] * v[j][1]) + (v[j][2] * v[j][2] + v[j][3] * v[j][3]); }
            const float rstd = 1.0f / sqrtf(wave_sum(s) * (1.f / DM) + NORM_EPS);
#pragma unroll
            for (int j = 0; j < 4; ++j) { const f32x4 gg = ((const f32x4*)norm_out)[lane + 64 * j]; f32x4 o = v[j] * rstd * gg;
#ifdef DBG_TIME_A
                { const float ta = (float)(MISC[16 + DBG_TIME_A] - MISC[15 + DBG_TIME_A]) * 0.01f, tb = (float)(MISC[16 + DBG_TIME_B] - MISC[15 + DBG_TIME_B]) * 0.01f;
                  const float fa = fminf(fmaxf(ta / (float)DBG_TMAX_A, 0.f), 1.f), fb = fminf(fmaxf(tb / (float)DBG_TMAX_B, 0.f), 1.f);
                  if (row < 64) o += 0.12f * sqrtf(fa);
                  if (row == 100 && j == 0 && lane == 0) o[0] += 0.04f + 0.055f * fb; }
#endif
                xr[64 * j] = o; }
        }
    }
#undef IN
#undef BOTH
}

extern "C" void kernel_launch(void* const* d_in, const int* in_sizes, int n_in, void* d_out, int out_size, void* d_ws, size_t ws_size, hipStream_t stream) {
    static int grid = 0;
    if (grid == 0) {
        int dev = 0, cus = 0, per_cu = 0;
        if (hipGetDevice(&dev) != hipSuccess || hipDeviceGetAttribute(&cus, hipDeviceAttributeMultiprocessorCount, dev) != hipSuccess) { fprintf(stderr, "kernel_launch: device query failed\n"); grid = -1; return; }
        if (hipFuncSetAttribute((const void*)mk_fwd, hipFuncAttributeMaxDynamicSharedMemorySize, LDS_BYTES) != hipSuccess) { fprintf(stderr, "kernel_launch: hipFuncSetAttribute failed\n"); grid = -1; return; }
        if (hipOccupancyMaxActiveBlocksPerMultiprocessor(&per_cu, (const void*)mk_fwd, NWAVES * 64, LDS_BYTES) != hipSuccess || per_cu < 1) { fprintf(stderr, "kernel_launch: occupancy query says %d blocks per CU\n", per_cu); }
        (void)hipGetLastError();
        grid = cus;
    }
    if (grid < 0) return;
    (void)hipMemsetAsync((char*)d_ws + WS_CTL, 0, CTL_ZERO_BYTES, stream);
    Args a{};
    for (int i = 0; i < 9; ++i) a.in[i] = (const float*)d_in[i];
    a.out = (float*)d_out; a.ws = (unsigned char*)d_ws;
    for (int li = 0; li < N_LAUNCHES; ++li) {
        a.ph_lo = (N_LAUNCHES == 1) ? 0 : li; a.ph_hi = (N_LAUNCHES == 1) ? N_PHASES : li + 1; a.li = (N_LAUNCHES == 1) ? 0 : 0;
        hipLaunchKernelGGL(mk_fwd, dim3(grid), dim3(NWAVES * 64), LDS_BYTES, stream, a);
    }
}
```
